# Optimizing an MI355X kernel written in HIP

```python
import jax, jax.numpy as jnp
from jax import lax
import numpy as np

D_MODEL = 1024
BATCH = 8
SEQ = 8192
DEPTH = 4

D_MIX = D_MODEL
MLA_HEADS = 4
MLA_NOPE = 128
MLA_ROPE = 64
MLA_V = 128
MLA_Q_RANK = 256
MLA_KV_RANK = 128
MLA_WIDTH = MLA_HEADS * MLA_V
ROPE_BASE = 10000.0
Q_BLOCK = 128
RWKV_WIDTH = D_MIX - MLA_WIDTH
RWKV_HEAD = 64
RWKV_HEADS = RWKV_WIDTH // RWKV_HEAD
DECAY_LORA = 64
AAA_LORA = 64
GATE_LORA = 128
GN_EPS = 64e-5
D_FF = 2816
CONV_W = 3
EPS = 1e-6
MLA_SIZES = (MLA_Q_RANK, MLA_KV_RANK, MLA_ROPE)
RWKV_SIZES = (RWKV_WIDTH, RWKV_WIDTH, RWKV_WIDTH, DECAY_LORA, DECAY_LORA, AAA_LORA, AAA_LORA, GATE_LORA)
MLA_IN = MLA_Q_RANK + MLA_KV_RANK + MLA_ROPE
RWKV_IN = 3 * RWKV_WIDTH + 2 * DECAY_LORA + 2 * AAA_LORA + GATE_LORA
D_IN = MLA_IN + RWKV_IN

kernel_name = 'hybrid_mla_rwkv7_convffn_adaln_encoder'


def rms_norm(x, gain=None, eps=EPS):
    xf = x.astype(jnp.float32)
    y = xf * lax.rsqrt(jnp.mean(xf * xf, axis=-1, keepdims=True) + eps)
    if gain is not None:
        y = y * gain.astype(jnp.float32)
    return y.astype(x.dtype)


def _split(z, sizes):
    offs = []
    acc = 0
    for s in sizes[:-1]:
        acc += s
        offs.append(acc)
    return jnp.split(z, offs, axis=-1)


def shift_prev(z):
    return jnp.pad(z, ((0, 0), (1, 0), (0, 0)))[:, :-1]


def shift_next(z):
    return jnp.pad(z, ((0, 0), (0, 1), (0, 0)))[:, 1:]


def centred_token_shift(z, mu):
    return z + mu[0] * (shift_prev(z) - z) + mu[1] * (shift_next(z) - z)


def rope_tables(pos):
    half = MLA_ROPE // 2
    inv_freq = ROPE_BASE ** (-jnp.arange(half, dtype=jnp.float32) / half)
    ang = pos.astype(jnp.float32)[..., None] * inv_freq
    return jnp.cos(ang), jnp.sin(ang)


def apply_rope(x, cos, sin):
    x1, x2 = jnp.split(x, 2, axis=-1)
    cos = cos.astype(x.dtype)
    sin = sin.astype(x.dtype)
    return jnp.concatenate([x1 * cos - x2 * sin, x2 * cos + x1 * sin], axis=-1)


def mla_group(q_lat, kv_lat, k_pe, positions, q_norm, w_uq, kv_norm, w_ukv, out_norm):
    B, S, _ = q_lat.shape
    H = MLA_HEADS
    q = (rms_norm(q_lat, q_norm) @ w_uq).reshape(B, S, H, MLA_NOPE + MLA_ROPE)
    q_nope, q_pe = q[..., :MLA_NOPE], q[..., MLA_NOPE:]
    kv = (rms_norm(kv_lat, kv_norm) @ w_ukv).reshape(B, S, H, MLA_NOPE + MLA_V)
    k_nope, v = kv[..., :MLA_NOPE], kv[..., MLA_NOPE:]
    cos, sin = rope_tables(positions)
    q_pe = apply_rope(q_pe, cos[:, :, None, :], sin[:, :, None, :])
    k_pe = apply_rope(k_pe, cos, sin)
    scale = (MLA_NOPE + MLA_ROPE) ** -0.5
    n_blk = S // Q_BLOCK
    qn_b = (q_nope * scale).reshape(B, n_blk, Q_BLOCK, H, MLA_NOPE).transpose(1, 0, 2, 3, 4)
    qp_b = (q_pe * scale).reshape(B, n_blk, Q_BLOCK, H, MLA_ROPE).transpose(1, 0, 2, 3, 4)

    def attend(blk):
        qn, qp = blk
        s = jnp.einsum('bqhd,bkhd->bhqk', qn, k_nope) + jnp.einsum('bqhr,bkr->bhqk', qp, k_pe)
        p = jax.nn.softmax(s.astype(jnp.float32), axis=-1).astype(v.dtype)
        return jnp.einsum('bhqk,bkhd->bqhd', p, v)

    o = lax.map(attend, (qn_b, qp_b))
    o = o.transpose(1, 0, 2, 3, 4).reshape(B, S, H * MLA_V)
    return rms_norm(o, out_norm)


def wkv7_scan(r, w, k, v, kk, a, reverse):
    B, S, H, N = r.shape
    xs = tuple(t.astype(jnp.float32).transpose(1, 0, 2, 3) for t in (r, w, k, v, kk, a))

    def step(state, inp):
        r_t, w_t, k_t, v_t, kk_t, a_t = inp
        sa = jnp.einsum('bhvk,bhk->bhv', state, -kk_t)
        state = (state * w_t[:, :, None, :]
                 + sa[..., None] * (kk_t * a_t)[:, :, None, :]
                 + v_t[..., None] * k_t[:, :, None, :])
        y = jnp.einsum('bhvk,bhk->bhv', state, r_t)
        return state, y

    state0 = jnp.zeros((B, H, N, N), jnp.float32)
    _, ys = lax.scan(step, state0, xs, reverse=reverse)
    return ys.transpose(1, 0, 2, 3)


def rwkv_decay(xw, w0, w2):
    wl = (w0 + jnp.tanh(xw) @ w2).astype(jnp.float32)
    wl = -jax.nn.softplus(-wl) - 0.5
    return jnp.exp(-jnp.exp(wl))


def rwkv7_group(r, k, v, xw_f, xw_b, xa_f, xa_b, xg, w0, w2, a0, a2, g2, k_k, k_a, r_k, gn_g, gn_b):
    B, S, W = r.shape
    H, N = RWKV_HEADS, RWKV_HEAD

    def heads(t):
        return t.reshape(B, S, H, N)

    g = jax.nn.sigmoid(xg) @ g2
    kk = heads(k * k_k).astype(jnp.float32)
    kk = kk * lax.rsqrt(jnp.sum(kk * kk, axis=-1, keepdims=True) + 1e-12)

    def direction(xw, xa, d, reverse):
        w = rwkv_decay(xw, w0[d], w2[d])
        a = jax.nn.sigmoid(a0[d] + xa @ a2[d])
        k_d = k * (1 + (a - 1) * k_a)
        y = wkv7_scan(heads(r), heads(w), heads(k_d), heads(v), kk, heads(a), reverse)
        return y, k_d

    y_f, k_f = direction(xw_f, xa_f, 0, False)
    y_b, k_b = direction(xw_b, xa_b, 1, True)
    y = y_f + y_b
    mu = jnp.mean(y, axis=-1, keepdims=True)
    var = jnp.mean(jnp.square(y - mu), axis=-1, keepdims=True)
    y = ((y - mu) * lax.rsqrt(var + GN_EPS)).reshape(B, S, W) * gn_g + gn_b
    k_bonus = 0.5 * (k_f + k_b)
    bonus = jnp.sum(heads(r * k_bonus) * r_k, axis=-1, keepdims=True) * heads(v)
    return (y.astype(r.dtype) + bonus.reshape(B, S, W)) * g


def conv_ffn(h, w_up, conv_w, conv_b, w_down):
    u = h @ w_up
    gate, val = u[..., :D_FF], u[..., D_FF:]
    gate = conv_w[0] * shift_prev(gate) + conv_w[1] * gate + conv_w[2] * shift_next(gate) + conv_b
    return (jax.nn.silu(gate) * val) @ w_down


def setup_inputs(seed: int = 0) -> dict:
    key = jax.random.key(seed)
    ks = jax.random.split(key, 28)
    f32 = jnp.float32
    L = DEPTH
    W = RWKV_WIDTH

    def nrm(k, shape, scale):
        return scale * jax.random.normal(k, shape, f32)

    x = nrm(ks[0], (BATCH, SEQ, D_MODEL), 1.0)
    c = nrm(ks[1], (BATCH, D_MODEL), 1.0)
    positions = (jnp.arange(SEQ, dtype=jnp.int32)[None, :]
                 + jax.random.randint(ks[2], (BATCH, 1), 0, 1024, dtype=jnp.int32))
    ada_w = nrm(ks[3], (L, D_MODEL, 6 * D_MODEL), 0.5 * D_MODEL ** -0.5)
    ada_b = nrm(ks[4], (L, 6 * D_MODEL), 0.02)
    w_in = nrm(ks[5], (L, D_MODEL, D_IN), D_MODEL ** -0.5)
    mla_q_norm = 1.0 + nrm(ks[6], (L, MLA_Q_RANK), 0.05)
    mla_w_uq = nrm(ks[7], (L, MLA_Q_RANK, MLA_HEADS * (MLA_NOPE + MLA_ROPE)), MLA_Q_RANK ** -0.5)
    mla_kv_norm = 1.0 + nrm(ks[8], (L, MLA_KV_RANK), 0.05)
    mla_w_ukv = nrm(ks[9], (L, MLA_KV_RANK, MLA_HEADS * (MLA_NOPE + MLA_V)), MLA_KV_RANK ** -0.5)
    mla_out_norm = 1.0 + nrm(ks[10], (L, MLA_WIDTH), 0.05)
    rwkv_mu = jax.random.uniform(ks[11], (L, 2, RWKV_IN), f32, 0.0, 0.5)
    rwkv_w0 = jax.random.uniform(ks[12], (L, 2, W), f32, -6.0, 1.0)
    rwkv_w2 = nrm(ks[13], (L, 2, DECAY_LORA, W), 0.5 * DECAY_LORA ** -0.5)
    rwkv_a0 = nrm(ks[14], (L, 2, W), 0.1)
    rwkv_a2 = nrm(ks[15], (L, 2, AAA_LORA, W), 0.5 * AAA_LORA ** -0.5)
    rwkv_g2 = nrm(ks[16], (L, GATE_LORA, W), GATE_LORA ** -0.5)
    rwkv_k_k = 0.85 + nrm(ks[17], (L, W), 0.05)
    rwkv_k_a = 1.0 + nrm(ks[18], (L, W), 0.05)
    rwkv_r_k = nrm(ks[19], (L, RWKV_HEADS, RWKV_HEAD), 0.1)
    rwkv_gn_g = 1.0 + nrm(ks[20], (L, W), 0.05)
    rwkv_gn_b = nrm(ks[21], (L, W), 0.02)
    w_out = nrm(ks[22], (L, D_MIX, D_MODEL), D_MIX ** -0.5)
    ffn_w_up = nrm(ks[23], (L, D_MODEL, 2 * D_FF), D_MODEL ** -0.5)
    ffn_conv_w = nrm(ks[24], (L, CONV_W, D_FF), CONV_W ** -0.5)
    ffn_conv_b = nrm(ks[25], (L, D_FF), 0.02)
    ffn_w_down = nrm(ks[26], (L, D_FF, D_MODEL), D_FF ** -0.5)
    final_norm = 1.0 + nrm(ks[27], (D_MODEL,), 0.05)
    return {'x': x, 'c': c, 'positions': positions, 'ada_w': ada_w, 'ada_b': ada_b, 'w_in': w_in,
            'mla_q_norm': mla_q_norm, 'mla_w_uq': mla_w_uq, 'mla_kv_norm': mla_kv_norm,
            'mla_w_ukv': mla_w_ukv, 'mla_out_norm': mla_out_norm, 'rwkv_mu': rwkv_mu,
            'rwkv_w0': rwkv_w0, 'rwkv_w2': rwkv_w2, 'rwkv_a0': rwkv_a0, 'rwkv_a2': rwkv_a2,
            'rwkv_g2': rwkv_g2, 'rwkv_k_k': rwkv_k_k, 'rwkv_k_a': rwkv_k_a, 'rwkv_r_k': rwkv_r_k,
            'rwkv_gn_g': rwkv_gn_g, 'rwkv_gn_b': rwkv_gn_b, 'w_out': w_out, 'ffn_w_up': ffn_w_up,
            'ffn_conv_w': ffn_conv_w, 'ffn_conv_b': ffn_conv_b, 'ffn_w_down': ffn_w_down,
            'final_norm': final_norm}


def reference(x, c, positions, ada_w, ada_b, w_in, mla_q_norm, mla_w_uq, mla_kv_norm, mla_w_ukv,
              mla_out_norm, rwkv_mu, rwkv_w0, rwkv_w2, rwkv_a0, rwkv_a2, rwkv_g2, rwkv_k_k,
              rwkv_k_a, rwkv_r_k, rwkv_gn_g, rwkv_gn_b, w_out, ffn_w_up, ffn_conv_w, ffn_conv_b,
              ffn_w_down, final_norm):
    c_act = jax.nn.silu(c)
    for l in range(DEPTH):
        mod = c_act @ ada_w[l] + ada_b[l]
        sh1, sc1, gt1, sh2, sc2, gt2 = [m[:, None, :] for m in jnp.split(mod, 6, axis=-1)]

        h = rms_norm(x) * (1 + sc1) + sh1
        z = h @ w_in[l]
        z_mla, z_rwkv = z[..., :MLA_IN], z[..., MLA_IN:]
        q_lat, kv_lat, k_pe = _split(z_mla, MLA_SIZES)
        z_rwkv = centred_token_shift(z_rwkv, rwkv_mu[l])
        r, k, v, xw_f, xw_b, xa_f, xa_b, xg = _split(z_rwkv, RWKV_SIZES)
        y_mla = mla_group(q_lat, kv_lat, k_pe, positions, mla_q_norm[l], mla_w_uq[l],
                          mla_kv_norm[l], mla_w_ukv[l], mla_out_norm[l])
        y_rwkv = rwkv7_group(r, k, v, xw_f, xw_b, xa_f, xa_b, xg, rwkv_w0[l], rwkv_w2[l],
                             rwkv_a0[l], rwkv_a2[l], rwkv_g2[l], rwkv_k_k[l], rwkv_k_a[l],
                             rwkv_r_k[l], rwkv_gn_g[l], rwkv_gn_b[l])
        x = x + gt1 * (jnp.concatenate([y_mla, y_rwkv], axis=-1) @ w_out[l])

        h = rms_norm(x) * (1 + sc2) + sh2
        x = x + gt2 * conv_ffn(h, ffn_w_up[l], ffn_conv_w[l], ffn_conv_b[l], ffn_w_down[l])
    return rms_norm(x, final_norm)
```

```cpp
#include <hip/hip_runtime.h>
#include <hip/hip_cooperative_groups.h>
#include <cstdio>
#include <cstdint>
namespace cg = cooperative_groups;

typedef unsigned short u16;
using bf16x8 = __attribute__((ext_vector_type(8))) short;
using f32x4 = __attribute__((ext_vector_type(4))) float;
#define DI __device__ __forceinline__

constexpr int T = 65536;
constexpr int S = 8192;
constexpr int DM = 1024;
constexpr int DFF = 2816;
constexpr int DIN = 2368;
constexpr int DINP = 2560;
constexpr int NLAYER = 4;
constexpr int NTHR = 512;
constexpr int LDS_BYTES = 131072 + 64;

constexpr size_t MB = 1ull << 20;
constexpr size_t WS_CNT = 0;
constexpr size_t WS_BAR = 1024;
constexpr size_t WS_MOD = 32768;
constexpr size_t WS_WIN = WS_MOD + 4ull * 8 * 6144 * 4;
constexpr size_t WS_WQ = WS_WIN + 4ull * DINP * 1024 * 2;
constexpr size_t WS_WUKV = WS_WQ + 4ull * 768 * 256 * 2;
constexpr size_t WS_W2 = WS_WUKV + 4ull * 1024 * 128 * 2;
constexpr size_t WS_A2 = WS_W2 + 4ull * 2 * 512 * 64 * 2;
constexpr size_t WS_G2 = WS_A2 + 4ull * 2 * 512 * 64 * 2;
constexpr size_t WS_WOUT = WS_G2 + 4ull * 512 * 128 * 2;
constexpr size_t WS_WUP = WS_WOUT + 4ull * 1024 * 1024 * 2;
constexpr size_t WS_WDN = WS_WUP + 4ull * 5632 * 1024 * 2;
constexpr size_t WS_ACT0 = ((WS_WDN + 4ull * 1024 * 2816 * 2) + 4095) & ~(size_t)4095;
constexpr size_t WS_H = WS_ACT0;
constexpr size_t WS_QN = WS_H;
constexpr size_t WS_LA = WS_H + (size_t)T * 256 * 2;
constexpr size_t WS_YF = WS_H;
constexpr size_t WS_YB = WS_H + (size_t)T * 512 * 2;
constexpr size_t WS_ZRKV = WS_H + (size_t)T * 1024 * 2;
constexpr size_t WS_ZREST = WS_ZRKV + (size_t)T * 1536 * 2;
constexpr size_t WS_OP = WS_ZREST;
constexpr size_t WS_AF = WS_ZREST + (size_t)T * 832 * 2;
constexpr size_t WS_AB = WS_AF + (size_t)T * 512 * 2;
constexpr size_t WS_GG = WS_AB + (size_t)T * 512 * 2;
constexpr size_t WS_EF = WS_GG + (size_t)T * 512 * 2;
constexpr size_t WS_EB = WS_EF + (size_t)T * 512 * 2;
constexpr size_t WS_CC = WS_EF;
constexpr size_t WS_QP = WS_EB + (size_t)T * 512 * 2;
constexpr size_t WS_OO = WS_QP;
constexpr size_t WS_KV = WS_QP + (size_t)T * 768 * 2;
constexpr size_t WS_VT = WS_KV + (size_t)T * 192 * 2;
constexpr size_t WS_END = WS_VT + (size_t)T * 128 * 2;
constexpr size_t WS_G = WS_ZRKV;
constexpr size_t WS_ACT = WS_G + (size_t)T * 2816 * 2;
static_assert(WS_ACT + (size_t)T * 2816 * 2 <= WS_END, "ffn overlay");
static_assert(WS_END <= 1073741824ull, "ws budget");

struct Params {
  const float* x; const float* c; const int* pos; const float* ada_w; const float* ada_b; const float* w_in;
  const float* q_norm; const float* w_uq; const float* kv_norm; const float* w_ukv; const float* out_norm;
  const float* mu; const float* w0; const float* w2; const float* a0; const float* a2; const float* g2;
  const float* k_k; const float* k_a; const float* r_k; const float* gn_g; const float* gn_b;
  const float* w_out; const float* w_up; const float* conv_w; const float* conv_b; const float* w_down;
  const float* final_norm;
  float* out; unsigned char* ws;
};

DI u16 f2bf(float f) { __bf16 b = (__bf16)f; return __builtin_bit_cast(u16, b); }
DI float bf2f(u16 h) { return __uint_as_float(((unsigned)h) << 16); }
typedef __bf16 bf16x2_t __attribute__((ext_vector_type(2)));
typedef float f32x2_t __attribute__((ext_vector_type(2)));
DI unsigned pack2(float a, float b) { f32x2_t v = {a, b}; bf16x2_t r = __builtin_convertvector(v, bf16x2_t); return __builtin_bit_cast(unsigned, r); }
DI float lo2f(unsigned u) { return __uint_as_float(u << 16); }
DI float hi2f(unsigned u) { return __uint_as_float(u & 0xffff0000u); }
template <int CTRL> DI float dpp_f(float x) { return __int_as_float(__builtin_amdgcn_update_dpp(0, __float_as_int(x), CTRL, 0xF, 0xF, true)); }
DI float red8(float x) { x += dpp_f<0xB1>(x); x += dpp_f<0x4E>(x); x += dpp_f<0x141>(x); return x; }
DI float xsum16(float x) { auto r = __builtin_amdgcn_permlane16_swap(__float_as_uint(x), __float_as_uint(x), false, false); return __uint_as_float(r[0]) + __uint_as_float(r[1]); }
DI float xsum32(float x) { auto r = __builtin_amdgcn_permlane32_swap(__float_as_uint(x), __float_as_uint(x), false, false); return __uint_as_float(r[0]) + __uint_as_float(r[1]); }
DI float wave_sum(float v) { v = red8(v); v += dpp_f<0x140>(v); return xsum32(xsum16(v)); }
DI float sigmoidf_(float x) { return __builtin_amdgcn_rcpf(1.f + __builtin_amdgcn_exp2f(-1.4426950408889634f * x)); }
DI void rope_cs(int pos, int i, float& c, float& s) {
  float inv = exp2f(-(float)i * 0.41524101186f);
  float ang = (float)pos * inv;
  float rev = ang * 0.15915494309189535f;
  rev = rev - floorf(rev);
  s = __builtin_amdgcn_sinf(rev);
  c = __builtin_amdgcn_cosf(rev);
}
DI int otid() { int t = threadIdx.x; asm volatile("" : "+v"(t)); return t; }
#define MFMA16(a, b, c) __builtin_amdgcn_mfma_f32_16x16x32_bf16((a), (b), (c), 0, 0, 0)

namespace pg8 {
#define PG8_LAS __attribute__((address_space(3)))
typedef unsigned short bf16_t;
constexpr int BM = 256, BK = 64, HALF = 128, HTB = HALF * BK * 2  , STAGE_BYTES = 8 * HTB, NXCD = 8, WGM = 8;
__host__ __device__ __forceinline__ int lds_byte(int r, int c) { const int st = (r >> 4) * 2 + (c >> 5), rr = r & 15, cc = c & 31, ob = rr * 64 + cc * 2; return st * 1024 + (ob ^ (((ob >> 9) & 1) << 5)); }
__host__ __device__ __forceinline__ void stage_rc(int b, int& R, int& C) { const int st = b / 1024, sb = b % 1024, swz = sb ^ (((sb >> 9) & 1) << 5); R = (st >> 1) * 16 + swz / 64; C = (st & 1) * 32 + (swz % 64) / 2; }
__host__ __device__ __forceinline__ int perm32(int rho) { const int n = rho >> 4, i = rho & 15; return 8 * (i >> 2) + 4 * n + (i & 3); }
struct Unit { int pm, pn; };
struct Gemm { const bf16_t* A; const bf16_t* Bt; int M, N, K; };
struct StaticOrder {
    int nM, nN, nwg, G, c;
    __host__ __device__ void init(int M, int N, int G_, int c_) { nM = M / BM; nN = N / BM; nwg = nM * nN; G = G_; c = c_; }
    __host__ __device__ bool next(int i, Unit& u) const {
        const long L = (long)i * G + c; if (L >= nwg) return false;
        int wgid = (int)L; { const int q = nwg / NXCD, r = nwg % NXCD, xcd = wgid % NXCD, off = wgid / NXCD; wgid = (xcd < r ? xcd * (q + 1) : r * (q + 1) + (xcd - r) * q) + off; }
        const int nig = WGM * nN, gid = wgid / nig, fm = gid * WGM, gsz = (nM - fm) < WGM ? (nM - fm) : WGM;
        u.pm = fm + ((wgid % nig) % gsz); u.pn = (wgid % nig) / gsz; return true;
    }
    __device__ __forceinline__ void a_ready(const Unit&) const {}
    __device__ __forceinline__ void done(const Unit&) const {}
};
template <class Epi, class Sched, bool STAMP = false>
__device__ __forceinline__ void gemm_phase(PG8_LAS unsigned char* lds, const Gemm g, const Sched& S, const Epi& E, unsigned long long* stamps) {
    const int tid = otid(), wid = __builtin_amdgcn_readfirstlane(tid >> 6), lane = tid & 63, wr = wid >> 2, wc = wid & 3, fr = lane & 15, fq = lane >> 4;
    const int K = g.K, nt = K / BK;
    unsigned voffA[2], voffB[2];
#pragma unroll
    for (int i = 0; i < 2; ++i) { int R, C; stage_rc(tid * 16 + i * 8192, R, C); const int Rb = Epi::PERM ? ((R & ~31) + perm32(R & 31)) : R;
        voffA[i] = (unsigned)(R * K + C) * 2u; voffB[i] = (unsigned)(Rb * K + C) * 2u; }
    const size_t kstep = (size_t)(BK * 2);
    const size_t hstep = (size_t)HALF * K * 2;
    const size_t tstep = 2 * hstep;
    const unsigned ldsw = (unsigned)wid * 1024u;
    const int aoff = lds_byte(wr * 64 + fr, fq * 8), boff = lds_byte(wc * 32 + fr, fq * 8);
#define PG8_SA(b, h) (((b) * 2 + (h)) * HTB)
#define PG8_SB(b, h) ((4 + (b) * 2 + (h)) * HTB)
#define PG8_STAGE(bufoff, gbase, voff) do { _Pragma("unroll") for (int _i = 0; _i < 2; ++_i) \
        __builtin_amdgcn_global_load_lds((const unsigned*)((const char*)(gbase) + (voff)[_i]), (PG8_LAS unsigned*)(lds + (bufoff) + ldsw + _i * 8192), 16, 0, 0); } while (0)
#define PG8_LDA(dst, b, h) do { _Pragma("unroll") for (int m = 0; m < 4; ++m) _Pragma("unroll") for (int k = 0; k < 2; ++k) dst[m][k] = *(const PG8_LAS bf16x8*)(lds + PG8_SA(b, h) + aoff + m * 2048 + k * 1024); } while (0)
#define PG8_LDB(dst, b, h) do { _Pragma("unroll") for (int n = 0; n < 2; ++n) _Pragma("unroll") for (int k = 0; k < 2; ++k) dst[n][k] = *(const PG8_LAS bf16x8*)(lds + PG8_SB(b, h) + boff + n * 2048 + k * 1024); } while (0)
#define PG8_MMA(ai, bj, At, Bt) do { __builtin_amdgcn_s_setprio(1); _Pragma("unroll") for (int m = 0; m < 4; ++m) _Pragma("unroll") for (int n = 0; n < 2; ++n) _Pragma("unroll") for (int k = 0; k < 2; ++k) \
        acc[ai][bj][m][n] = __builtin_amdgcn_mfma_f32_16x16x32_bf16(Bt[n][k], At[m][k], acc[ai][bj][m][n], 0, 0, 0); __builtin_amdgcn_s_setprio(0); } while (0)
#define PG8_WAIT_V(n) asm volatile("s_waitcnt vmcnt(" #n ")" ::: "memory")
#define PG8_WAIT_L(n) asm volatile("s_waitcnt lgkmcnt(" #n ")" ::: "memory")
#define PG8_BAR __builtin_amdgcn_s_barrier()
#define PG8_SCHED __builtin_amdgcn_sched_barrier(0)
    Unit cur, nxt; int ui = 0;
    if (!S.next(0, cur)) return;
    f32x4 acc[2][2][4][2];
#pragma unroll
    for (int a = 0; a < 2; ++a)
#pragma unroll
        for (int b = 0; b < 2; ++b)
#pragma unroll
            for (int m = 0; m < 4; ++m)
#pragma unroll
                for (int n = 0; n < 2; ++n) acc[a][b][m][n] = (f32x4){0.f, 0.f, 0.f, 0.f};
    bf16x8 At[4][2], B0[2][2], B1[2][2];
    const char* cA = (const char*)g.A + (size_t)cur.pm * tstep; const char* cB = (const char*)g.Bt + (size_t)cur.pn * tstep;
    S.a_ready(cur);
    PG8_STAGE(PG8_SB(0, 0), cB, voffB); PG8_STAGE(PG8_SA(0, 0), cA, voffA); PG8_STAGE(PG8_SB(0, 1), cB + hstep, voffB); PG8_STAGE(PG8_SA(0, 1), cA + hstep, voffA);
    if (wr == 1) PG8_BAR;
    PG8_WAIT_V(4); PG8_BAR;
    PG8_STAGE(PG8_SB(1, 0), cB + kstep, voffB); PG8_STAGE(PG8_SA(1, 0), cA + kstep, voffA); PG8_STAGE(PG8_SB(1, 1), cB + hstep + kstep, voffB);
    PG8_WAIT_V(6); PG8_BAR;
    for (;;) {
        const bool has_next = S.next(ui + 1, nxt);
        const char* nA = has_next ? (const char*)g.A + (size_t)nxt.pm * tstep : cA; const char* nB = has_next ? (const char*)g.Bt + (size_t)nxt.pn * tstep : cB;
        for (int t = 0; t < nt; t += 2) {
            const bool last = (t == nt - 2);
            const char* a1 = cA + (size_t)(t + 1) * kstep;
            const char* a2 = last ? nA : cA + (size_t)(t + 2) * kstep; const char* b2 = last ? nB : cB + (size_t)(t + 2) * kstep;
            const char* a3 = a2 + kstep; const char* b3 = b2 + kstep;
            if (last && has_next) S.a_ready(nxt);
            PG8_LDB(B0, 0, 0); PG8_SCHED; PG8_LDA(At, 0, 0); PG8_STAGE(PG8_SA(1, 1), a1 + hstep, voffA);
            PG8_WAIT_L(8); PG8_BAR; PG8_WAIT_L(0); PG8_MMA(0, 0, At, B0); PG8_BAR; PG8_SCHED;
            PG8_LDB(B1, 0, 1); PG8_STAGE(PG8_SB(0, 0), b2, voffB);
            PG8_BAR; PG8_WAIT_L(0); PG8_MMA(0, 1, At, B1); PG8_BAR;
            PG8_LDA(At, 0, 1); PG8_STAGE(PG8_SA(0, 0), a2, voffA);
            PG8_BAR; PG8_WAIT_L(0); PG8_MMA(1, 0, At, B0); PG8_BAR; PG8_SCHED;
            PG8_STAGE(PG8_SB(0, 1), b2 + hstep, voffB);
            PG8_WAIT_V(6); PG8_BAR; PG8_MMA(1, 1, At, B1); PG8_BAR;
            PG8_LDB(B0, 1, 0); PG8_SCHED; PG8_LDA(At, 1, 0); PG8_STAGE(PG8_SA(0, 1), a2 + hstep, voffA);
            PG8_WAIT_L(8); PG8_BAR; PG8_WAIT_L(0); PG8_MMA(0, 0, At, B0); PG8_BAR; PG8_SCHED;
            PG8_LDB(B1, 1, 1); PG8_STAGE(PG8_SB(1, 0), b3, voffB);
            PG8_BAR; PG8_WAIT_L(0); PG8_MMA(0, 1, At, B1); PG8_BAR;
            PG8_LDA(At, 1, 1); PG8_STAGE(PG8_SA(1, 0), a3, voffA);
            PG8_BAR; PG8_WAIT_L(0); PG8_MMA(1, 0, At, B0); PG8_BAR; PG8_SCHED;
            PG8_STAGE(PG8_SB(1, 1), b3 + hstep, voffB);
            PG8_WAIT_V(6); PG8_BAR; PG8_MMA(1, 1, At, B1); PG8_BAR;
        }
        if constexpr (!Epi::AFTER_DRAIN) { E(acc, cur, wr, wc, fr, fq); S.done(cur); }
        if (!has_next) break;
#pragma unroll
        for (int a = 0; a < 2; ++a)
#pragma unroll
            for (int b = 0; b < 2; ++b)
#pragma unroll
                for (int m = 0; m < 4; ++m)
#pragma unroll
                    for (int n = 0; n < 2; ++n) acc[a][b][m][n] = (f32x4){0.f, 0.f, 0.f, 0.f};
        cur = nxt; cA = nA; cB = nB; ++ui;
    }
    PG8_WAIT_V(0);
    if (wr == 0) PG8_BAR;
    PG8_BAR;
    if constexpr (Epi::AFTER_DRAIN) { E.fused(acc, cur, wr, wc, fr, fq, lds, wid, lane); S.done(cur); }
#undef PG8_SA
#undef PG8_SB
#undef PG8_STAGE
#undef PG8_LDA
#undef PG8_LDB
#undef PG8_MMA
#undef PG8_WAIT_V
#undef PG8_WAIT_L
#undef PG8_BAR
#undef PG8_SCHED
}
}

DI void store_bf4(u16* p, f32x4 v);
struct BigEpi {
  static constexpr bool PERM = true, AFTER_DRAIN = false;
  int mode, N, ld; u16* o0; u16* o1; const float* xin; float* xout; const float* gate; const float* cw; const float* cb;
  DI void f_z(int m, int n, f32x4 v) const {
    u16* dst;
    if (n < 448) dst = o0 + (size_t)m * 832 + n;
    else if (n < 1984) dst = o1 + (size_t)m * 1536 + (n - 448);
    else dst = o0 + (size_t)m * 832 + (n - 1984 + 448);
    store_bf4(dst, v);
  }
  DI void f_store(int m, int n, f32x4 v) const { store_bf4(o0 + (size_t)m * ld + n, v); }
  DI static void st8(u16* dst, f32x4 v0, f32x4 v1) {
    uint4 o; o.x = pack2(v0[0], v0[1]); o.y = pack2(v0[2], v0[3]); o.z = pack2(v1[0], v1[1]); o.w = pack2(v1[2], v1[3]);
    *(uint4*)dst = o;
  }
  DI void f_z8(int m, int n, f32x4 v0, f32x4 v1) const {
    u16* dst;
    if (n < 448) dst = o0 + (size_t)m * 832 + n;
    else if (n < 1984) dst = o1 + (size_t)m * 1536 + (n - 448);
    else dst = o0 + (size_t)m * 832 + (n - 1984 + 448);
    st8(dst, v0, v1);
  }
  DI void f_store8(int m, int n, f32x4 v0, f32x4 v1) const { st8(o0 + (size_t)m * ld + n, v0, v1); }
  DI void f_res(int m, int n, f32x4 v) const {
    const float4 g = *(const float4*)(gate + (size_t)(m >> 13) * 6144 + n);
    const float4 xi = *(const float4*)(xin + (size_t)m * DM + n);
    float4 o = {xi.x + g.x * v[0], xi.y + g.y * v[1], xi.z + g.z * v[2], xi.w + g.w * v[3]};
    *(float4*)(xout + (size_t)m * DM + n) = o;
  }
  DI void operator()(const f32x4 (&acc)[2][2][4][2], const pg8::Unit& u, int wr, int wc, int fr, int fq) const {
    const int row0 = u.pm * 256 + wr * 64 + fr, col0 = u.pn * 256 + wc * 32 + 8 * fq;
#define BIGEPI_LOOP(F, CHK) \
    _Pragma("unroll") for (int ai = 0; ai < 2; ++ai) _Pragma("unroll") for (int m = 0; m < 4; ++m) { \
      _Pragma("unroll") for (int bj = 0; bj < 2; ++bj) { \
        const int c = col0 + bj * 128; \
        if (!(CHK) || c < N) F(row0 + ai * 128 + m * 16, c, acc[ai][bj][m][0], acc[ai][bj][m][1]); } \
      __builtin_amdgcn_sched_barrier(0); }
    if (mode == 0) { if (u.pn == (DINP / 256 - 1)) { BIGEPI_LOOP(f_z8, true) } else { BIGEPI_LOOP(f_z8, false) } }
    else if (mode == 1) { BIGEPI_LOOP(f_store8, false) }
    else if (mode == 2) {
      const float* gp = gate + (size_t)(row0 >> 13) * 6144 + col0;
      float4 gt[2][2];
#pragma unroll
      for (int bj = 0; bj < 2; ++bj)
#pragma unroll
        for (int n = 0; n < 2; ++n) gt[bj][n] = *(const float4*)(gp + bj * 128 + n * 4);
#pragma unroll
      for (int ai = 0; ai < 2; ++ai)
#pragma unroll
        for (int mh = 0; mh < 2; ++mh) {
          float4 xv[2][2][2];
#pragma unroll
          for (int mm = 0; mm < 2; ++mm)
#pragma unroll
            for (int bj = 0; bj < 2; ++bj)
#pragma unroll
              for (int n = 0; n < 2; ++n)
                xv[mm][bj][n] = *(const float4*)(xin + (size_t)(row0 + ai * 128 + (mh * 2 + mm) * 16) * DM + col0 + bj * 128 + n * 4);
          __builtin_amdgcn_sched_barrier(0);
#pragma unroll
          for (int mm = 0; mm < 2; ++mm)
#pragma unroll
            for (int bj = 0; bj < 2; ++bj)
#pragma unroll
              for (int n = 0; n < 2; ++n) {
                const f32x4 v = acc[ai][bj][mh * 2 + mm][n];
                const float4 xi = xv[mm][bj][n], g = gt[bj][n];
                float4 o = {xi.x + g.x * v[0], xi.y + g.y * v[1], xi.z + g.z * v[2], xi.w + g.w * v[3]};
                *(float4*)(xout + (size_t)(row0 + ai * 128 + (mh * 2 + mm) * 16) * DM + col0 + bj * 128 + n * 4) = o;
              }
          __builtin_amdgcn_sched_barrier(0);
        }
    } else {
#pragma unroll
      for (int ai = 0; ai < 2; ++ai) {
        uint4 gs[4][2];
#pragma unroll
        for (int m = 0; m < 4; ++m)
#pragma unroll
          for (int bj = 0; bj < 2; ++bj)
            gs[m][bj] = *(const uint4*)(o0 + (size_t)(row0 + ai * 128 + m * 16) * DFF + col0 + bj * 128);
        __builtin_amdgcn_sched_barrier(0);
#pragma unroll
        for (int m = 0; m < 4; ++m)
#pragma unroll
          for (int bj = 0; bj < 2; ++bj) {
            const f32x4 v0 = acc[ai][bj][m][0], v1 = acc[ai][bj][m][1];
            const uint4 g = gs[m][bj];
            f32x4 q0 = {lo2f(g.x) * v0[0], hi2f(g.x) * v0[1], lo2f(g.y) * v0[2], hi2f(g.y) * v0[3]};
            f32x4 q1 = {lo2f(g.z) * v1[0], hi2f(g.z) * v1[1], lo2f(g.w) * v1[2], hi2f(g.w) * v1[3]};
            st8(o0 + (size_t)(row0 + ai * 128 + m * 16) * DFF + col0 + bj * 128, q0, q1);
          }
        __builtin_amdgcn_sched_barrier(0);
      }
    }
#undef BIGEPI_LOOP
  }
};
DI void gemm_big(char* smem, const u16* A, const u16* Bt, int Npad, int K, const BigEpi& E) {
  pg8::StaticOrder so; so.init(T, Npad, (int)gridDim.x, (int)blockIdx.x);
  pg8::Gemm g{A, Bt, T, Npad, K};
  pg8::gemm_phase<BigEpi, pg8::StaticOrder, false>((PG8_LAS unsigned char*)smem, g, so, E, nullptr);
}

template <class Epi>
DI void gemm_small(const u16* __restrict__ A, int lda, const u16* __restrict__ Bt, int ldb, int N, int K, u16* __restrict__ O, int ldo, Epi epi,
                   char* smem, int& rot) {
  const int tid = otid(), lane = tid & 63, wave = tid >> 6;
  const int wm = wave >> 1, wn = wave & 1, r16 = lane & 15, quad = lane >> 4;
  u16* sA = (u16*)smem;
  u16* sB = sA + 2 * 256 * 48;
  const int NT = (N + 127) >> 7;
  const int ntiles = 256 * NT;
  const int ldrow = tid >> 2, ldkc = tid & 3;
  const int KT = K >> 5;
  int first = (int)blockIdx.x - rot;
  if (first < 0) first += gridDim.x;
  rot = (rot + ntiles) % (int)gridDim.x;
  for (int tile = first; tile < ntiles; tile += gridDim.x) {
    const int grp = tile / (8 * NT), rem = tile - grp * 8 * NT;
    const int mt = grp * 8 + (rem & 7), nt = rem >> 3;
    const int m0 = mt << 8, n0 = nt << 7;
    const u16* Ap = A + (size_t)(m0 + ldrow) * lda + ldkc * 8;
    const u16* Bp = Bt + (size_t)(n0 + (ldrow & ~31) + pg8::perm32(ldrow & 31)) * ldb + ldkc * 8;
    uint4 ra0 = *(const uint4*)Ap, ra1 = *(const uint4*)(Ap + (size_t)128 * lda);
    uint4 rb0 = *(const uint4*)Bp;
    f32x4 acc[4][4];
#pragma unroll
    for (int i = 0; i < 4; ++i)
#pragma unroll
      for (int j = 0; j < 4; ++j) acc[i][j] = (f32x4){0.f, 0.f, 0.f, 0.f};
    *(uint4*)(sA + ldrow * 48 + ldkc * 8) = ra0;
    *(uint4*)(sA + (ldrow + 128) * 48 + ldkc * 8) = ra1;
    *(uint4*)(sB + ldrow * 48 + ldkc * 8) = rb0;
    __syncthreads();
    for (int kt = 0; kt < KT; ++kt) {
      const int cur = kt & 1;
      if (kt + 1 < KT) {
        const int ko = (kt + 1) << 5;
        ra0 = *(const uint4*)(Ap + ko); ra1 = *(const uint4*)(Ap + (size_t)128 * lda + ko);
        rb0 = *(const uint4*)(Bp + ko);
      }
      const u16* as = sA + cur * 256 * 48 + (wm * 64 + r16) * 48 + quad * 8;
      const u16* bs = sB + cur * 128 * 48 + (wn * 64 + r16) * 48 + quad * 8;
      bf16x8 af[4], bfr[4];
#pragma unroll
      for (int i = 0; i < 4; ++i) { af[i] = *(const bf16x8*)(as + i * 16 * 48); bfr[i] = *(const bf16x8*)(bs + i * 16 * 48); }
#pragma unroll
      for (int mi = 0; mi < 4; ++mi)
#pragma unroll
        for (int ni = 0; ni < 4; ++ni) acc[mi][ni] = MFMA16(bfr[ni], af[mi], acc[mi][ni]);
      if (kt + 1 < KT) {
        u16* a2 = sA + (cur ^ 1) * 256 * 48; u16* b2 = sB + (cur ^ 1) * 128 * 48;
        *(uint4*)(a2 + ldrow * 48 + ldkc * 8) = ra0;
        *(uint4*)(a2 + (ldrow + 128) * 48 + ldkc * 8) = ra1;
        *(uint4*)(b2 + ldrow * 48 + ldkc * 8) = rb0;
      }
      __syncthreads();
    }
#pragma unroll
    for (int mi = 0; mi < 4; ++mi) {
#pragma unroll
      for (int np = 0; np < 2; ++np) {
        const int m = m0 + wm * 64 + mi * 16 + r16;
        const int n = n0 + wn * 64 + np * 32 + quad * 8;
        if (n < N) {
          const f32x4 v0 = epi(n, acc[mi][2 * np]), v1 = epi(n + 4, acc[mi][2 * np + 1]);
          uint4 o; o.x = pack2(v0[0], v0[1]); o.y = pack2(v0[2], v0[3]); o.z = pack2(v1[0], v1[1]); o.w = pack2(v1[2], v1[3]);
          *(uint4*)(O + (size_t)m * ldo + n) = o;
        }
      }
      __builtin_amdgcn_sched_barrier(0);
    }
  }
}

DI void store_bf4(u16* p, f32x4 v) { uint2 o; o.x = pack2(v[0], v[1]); o.y = pack2(v[2], v[3]); *(uint2*)p = o; }

DI void tr_phase(const float* __restrict__ src, int ld, int K, int N, u16* __restrict__ dst, char* smem, int& rot) {
  float* tl = (float*)smem;
  const int tid = otid();
  const int KTn = K >> 5, NTn = N >> 5, ntiles = KTn * NTn;
  int first = (int)blockIdx.x - rot;
  if (first < 0) first += gridDim.x;
  rot = (rot + ntiles) % (int)gridDim.x;
  const int a = tid >> 5, bq = tid & 31;
  for (int tile = first; tile < ntiles; tile += gridDim.x) {
    const int kt = tile / NTn, nt = tile - kt * NTn;
    __syncthreads();
#pragma unroll
    for (int i = 0; i < 2; ++i) tl[(a + 16 * i) * 33 + bq] = src[(size_t)(kt * 32 + a + 16 * i) * ld + nt * 32 + bq];
    __syncthreads();
#pragma unroll
    for (int i = 0; i < 2; ++i) dst[(size_t)(nt * 32 + a + 16 * i) * K + kt * 32 + bq] = f2bf(tl[bq * 33 + a + 16 * i]);
  }
}

DI void norm_mod_phase(const float* __restrict__ X, const float* __restrict__ modl, int sh_off, int sc_off, u16* __restrict__ H) {
  const int tid_ = otid(); const int lane = tid_ & 63;
  const int gw = (blockIdx.x * NTHR + tid_) >> 6, nw = (gridDim.x * NTHR) >> 6;
  for (int t = gw * 4; t < T; t += nw * 4) {
    const float* mb = modl + (size_t)(t >> 13) * 6144;
    const float4* xr = (const float4*)(X + (size_t)t * DM);
    float4 v[4][4];
#pragma unroll
    for (int k = 0; k < 4; ++k)
#pragma unroll
      for (int i = 0; i < 4; ++i) v[k][i] = xr[k * 256 + lane + 64 * i];
    float rs[4];
#pragma unroll
    for (int k = 0; k < 4; ++k) {
      float ss = 0.f;
#pragma unroll
      for (int i = 0; i < 4; ++i) ss += v[k][i].x * v[k][i].x + v[k][i].y * v[k][i].y + v[k][i].z * v[k][i].z + v[k][i].w * v[k][i].w;
      rs[k] = rsqrtf(wave_sum(ss) * (1.f / 1024.f) + 1e-6f);
    }
#pragma unroll
    for (int i = 0; i < 4; ++i) {
      const int c = (lane + 64 * i) * 4;
      const float4 sc = *(const float4*)(mb + sc_off + c), sh = *(const float4*)(mb + sh_off + c);
#pragma unroll
      for (int k = 0; k < 4; ++k) {
        uint2 o;
        o.x = pack2(v[k][i].x * rs[k] * (1.f + sc.x) + sh.x, v[k][i].y * rs[k] * (1.f + sc.y) + sh.y);
        o.y = pack2(v[k][i].z * rs[k] * (1.f + sc.z) + sh.z, v[k][i].w * rs[k] * (1.f + sc.w) + sh.w);
        *(uint2*)(H + (size_t)(t + k) * DM + c) = o;
      }
    }
  }
}

DI void prep_phase(const Params& p, int l) {
  const u16* ZR = (const u16*)(p.ws + WS_ZREST);
  u16* QN = (u16*)(p.ws + WS_QN); u16* LA = (u16*)(p.ws + WS_LA); u16* KV = (u16*)(p.ws + WS_KV); u16* VT = (u16*)(p.ws + WS_VT);
  const float* qn_w = p.q_norm + l * 256; const float* kvn_w = p.kv_norm + l * 128;
  const float* mu0 = p.mu + (size_t)l * 2 * 1920 + 1536; const float* mu1 = mu0 + 1920;
  const int tid_ = otid(); const int lane = tid_ & 63;
  const int gw = (blockIdx.x * NTHR + tid_) >> 6, nw = (gridDim.x * NTHR) >> 6;
  const float4 qw = *(const float4*)(qn_w + lane * 4);
  const float2 kw = *(const float2*)(kvn_w + lane * 2);
  for (int grp = gw; grp < T / 8; grp += nw) {
    const int t0 = grp * 8;
    unsigned vt0[4], vt1[4];
#pragma unroll
    for (int tt = 0; tt < 8; ++tt) {
      const int t = t0 + tt, s = t & (S - 1);
      const u16* zr = ZR + (size_t)t * 832;
      {
        const uint2 q = *(const uint2*)(zr + lane * 4);
        const float a = lo2f(q.x), b = hi2f(q.x), c = lo2f(q.y), d = hi2f(q.y);
        const float ss = wave_sum(a * a + b * b + c * c + d * d);
        const float rstd = rsqrtf(ss * (1.f / 256.f) + 1e-6f);
        uint2 o; o.x = pack2(a * rstd * qw.x, b * rstd * qw.y); o.y = pack2(c * rstd * qw.z, d * rstd * qw.w);
        *(uint2*)(QN + (size_t)t * 256 + lane * 4) = o;
      }
      {
        const unsigned q = *(const unsigned*)(zr + 256 + lane * 2);
        const float a = lo2f(q), b = hi2f(q);
        const float ss = wave_sum(a * a + b * b);
        const float rstd = rsqrtf(ss * (1.f / 128.f) + 1e-6f);
        const u16 o0 = f2bf(a * rstd * kw.x), o1 = f2bf(b * rstd * kw.y);
        *(unsigned*)(KV + (size_t)t * 192 + lane * 2) = (unsigned)o0 | ((unsigned)o1 << 16);
        if (tt & 1) { vt0[tt >> 1] |= (unsigned)o0 << 16; vt1[tt >> 1] |= (unsigned)o1 << 16; }
        else { vt0[tt >> 1] = o0; vt1[tt >> 1] = o1; }
      }
      {
        const int i = lane & 31;
        const float x1 = bf2f(zr[384 + i]), x2 = bf2f(zr[416 + i]);
        float cs, sn; rope_cs(p.pos[t], i, cs, sn);
        const float o = (lane < 32) ? (x1 * cs - x2 * sn) : (x2 * cs + x1 * sn);
        KV[(size_t)t * 192 + 128 + lane] = f2bf(o);
      }
#pragma unroll
      for (int i = 0; i < 3; ++i) {
        const int cl = lane * 2 + 128 * i;
        const unsigned zc = *(const unsigned*)(zr + 448 + cl);
        const unsigned zp = (s > 0) ? *(const unsigned*)(zr - 832 + 448 + cl) : 0u;
        const unsigned zn = (s < S - 1) ? *(const unsigned*)(zr + 832 + 448 + cl) : 0u;
        const float2 m0 = *(const float2*)(mu0 + cl), m1 = *(const float2*)(mu1 + cl);
        float a = lo2f(zc), b = hi2f(zc);
        a = a + m0.x * (lo2f(zp) - a) + m1.x * (lo2f(zn) - a);
        b = b + m0.y * (hi2f(zp) - b) + m1.y * (hi2f(zn) - b);
        if (i == 0) { a = 1.f - 2.f * __builtin_amdgcn_rcpf(1.f + __builtin_amdgcn_exp2f(2.885390081777927f * a)); b = 1.f - 2.f * __builtin_amdgcn_rcpf(1.f + __builtin_amdgcn_exp2f(2.885390081777927f * b)); }
        else if (i == 2) { a = sigmoidf_(a); b = sigmoidf_(b); }
        *(unsigned*)(LA + (size_t)t * 384 + cl) = pack2(a, b);
      }
    }
    const int b = t0 >> 13, s0 = t0 & (S - 1);
    uint4 o0 = make_uint4(vt0[0], vt0[1], vt0[2], vt0[3]), o1 = make_uint4(vt1[0], vt1[1], vt1[2], vt1[3]);
    *(uint4*)(VT + ((size_t)b * 128 + lane * 2) * S + s0) = o0;
    *(uint4*)(VT + ((size_t)b * 128 + lane * 2 + 1) * S + s0) = o1;
  }
}

DI float xmax16(float x) { auto r = __builtin_amdgcn_permlane16_swap(__float_as_uint(x), __float_as_uint(x), false, false); return fmaxf(__uint_as_float(r[0]), __uint_as_float(r[1])); }
DI float xmax32(float x) { auto r = __builtin_amdgcn_permlane32_swap(__float_as_uint(x), __float_as_uint(x), false, false); return fmaxf(__uint_as_float(r[0]), __uint_as_float(r[1])); }
DI void attn_item(const Params& p, int item, char* smem) {
  const int tid = otid(), lane = tid & 63, wave = tid >> 6, r16 = lane & 15, quad = lane >> 4;
  const int h = item & 3, qb = (item >> 2) & 31, b = item >> 7;
  const u16* QP = (const u16*)(p.ws + WS_QP);
  const u16* Kg = (const u16*)(p.ws + WS_KV) + (size_t)b * S * 192;
  const u16* Vg = (const u16*)(p.ws + WS_VT) + (size_t)b * 128 * S;
  u16* OP = (u16*)(p.ws + WS_OP);
  u16* sK = (u16*)smem;
  u16* sV = sK + 64 * 208;
  const int tq0 = b * S + qb * 256 + wave * 32;
  bf16x8 qf[2][6];
#pragma unroll
  for (int g = 0; g < 2; ++g) {
    const int t = tq0 + g * 16 + r16;
    const u16* qp = QP + (size_t)t * 768 + h * 192 + quad * 8;
#pragma unroll
    for (int ks = 0; ks < 6; ++ks) qf[g][ks] = *(const bf16x8*)(qp + ks * 32);
    const int ps = p.pos[t];
#pragma unroll
    for (int j = 0; j < 8; ++j) {
      float cs, sn; rope_cs(ps, quad * 8 + j, cs, sn);
      const float x1 = bf2f((u16)qf[g][4][j]), x2 = bf2f((u16)qf[g][5][j]);
      qf[g][4][j] = (short)f2bf(x1 * cs - x2 * sn);
      qf[g][5][j] = (short)f2bf(x2 * cs + x1 * sn);
    }
  }
  f32x4 oacc[2][8];
#pragma unroll
  for (int g = 0; g < 2; ++g)
#pragma unroll
    for (int d = 0; d < 8; ++d) oacc[g][d] = (f32x4){0.f, 0.f, 0.f, 0.f};
  float m_run[2] = {-INFINITY, -INFINITY}, l_run[2] = {0.f, 0.f};
  const float cscale = 0.07216878364870322f * 1.4426950408889634f;
  const int vrow = tid >> 3, vcc = tid & 7;
#define KLD(i, base) *(const uint4*)((base) + (size_t)(tid + NTHR * (i)) * 8)
#define VLD(i, ko) *(const uint4*)(Vg + (size_t)(vrow + 64 * (i)) * S + (ko) + vcc * 8)
  uint4 rk0 = KLD(0, Kg), rk1 = KLD(1, Kg), rk2 = KLD(2, Kg);
  uint4 rv0 = VLD(0, 0), rv1 = VLD(1, 0);
#define KST(i, r) { const int c = tid + NTHR * (i); const int row = c / 24, cc = c - row * 24; *(uint4*)(sK + row * 208 + cc * 8) = r; }
#define VPERM(a_) (((((a_) >> 5) * 2 + (((a_) >> 2) & 1)) << 4) | ((((a_) >> 3) & 3) << 2) | ((a_) & 3))
#define VST(i, r) *(uint4*)(sV + VPERM(vrow + 64 * (i)) * 72 + vcc * 8) = r;
  KST(0, rk0) KST(1, rk1) KST(2, rk2)
  VST(0, rv0) VST(1, rv1)
  __syncthreads();
  { const u16* kn = Kg + (size_t)64 * 192; rk0 = KLD(0, kn); rk1 = KLD(1, kn); rk2 = KLD(2, kn); rv0 = VLD(0, 64); rv1 = VLD(1, 64); }
  for (int kt = 0; kt < S / 64; ++kt) {
    sK = (u16*)smem + (kt & 1) * 22528;
    sV = sK + 64 * 208;
    f32x4 sacc[2][4];
#pragma unroll
    for (int g = 0; g < 2; ++g)
#pragma unroll
      for (int kb = 0; kb < 4; ++kb) sacc[g][kb] = (f32x4){0.f, 0.f, 0.f, 0.f};
    {
      bf16x8 kfa[4], kfb[4];
#define KFLD(dst, ks) _Pragma("unroll") for (int kb = 0; kb < 4; ++kb) dst[kb] = *(const bf16x8*)(sK + (kb * 16 + r16) * 208 + (ks) * 32 + quad * 8);
#define KFMM(src, ks) _Pragma("unroll") for (int kb = 0; kb < 4; ++kb) { sacc[0][kb] = MFMA16(src[kb], qf[0][ks], sacc[0][kb]); sacc[1][kb] = MFMA16(src[kb], qf[1][ks], sacc[1][kb]); }
      KFLD(kfa, 0)
      __builtin_amdgcn_sched_barrier(0);
      KFLD(kfb, 1) KFMM(kfa, 0)
      __builtin_amdgcn_sched_barrier(0);
      KFLD(kfa, 2) KFMM(kfb, 1)
      __builtin_amdgcn_sched_barrier(0);
      KFLD(kfb, 3) KFMM(kfa, 2)
      __builtin_amdgcn_sched_barrier(0);
      KFLD(kfa, 4) KFMM(kfb, 3)
      __builtin_amdgcn_sched_barrier(0);
      KFLD(kfb, 5) KFMM(kfa, 4)
      __builtin_amdgcn_sched_barrier(0);
      KFMM(kfb, 5)
      __builtin_amdgcn_sched_barrier(0);
    }
    bf16x8 pf[2][2];
#pragma unroll
    for (int g = 0; g < 2; ++g) {
      float mx = sacc[g][0][0];
#pragma unroll
      for (int kb = 0; kb < 4; ++kb)
#pragma unroll
        for (int j = 0; j < 4; ++j) mx = fmaxf(mx, sacc[g][kb][j]);
      mx = xmax32(xmax16(mx));
      const float m_old = m_run[g];
      float alpha = 1.f;
      if (__builtin_amdgcn_ballot_w64((mx - m_old) * cscale > 11.5415603f) != 0ull) {
        const float mnew = fmaxf(m_old, mx);
        alpha = __builtin_amdgcn_exp2f((m_old - mnew) * cscale);
        m_run[g] = mnew;
#pragma unroll
        for (int d = 0; d < 8; ++d) oacc[g][d] *= alpha;
      }
      const float ms = m_run[g] * cscale;
      float rs = 0.f;
      float pv[4][4];
#pragma unroll
      for (int kb = 0; kb < 4; ++kb)
#pragma unroll
        for (int j = 0; j < 4; ++j) { pv[kb][j] = __builtin_amdgcn_exp2f(sacc[g][kb][j] * cscale - ms); rs += pv[kb][j]; }
      l_run[g] = l_run[g] * alpha + rs;
#pragma unroll
      for (int s2 = 0; s2 < 2; ++s2) {
        { uint4 pk; pk.x = pack2(pv[2 * s2][0], pv[2 * s2][1]); pk.y = pack2(pv[2 * s2][2], pv[2 * s2][3]);
          pk.z = pack2(pv[2 * s2 + 1][0], pv[2 * s2 + 1][1]); pk.w = pack2(pv[2 * s2 + 1][2], pv[2 * s2 + 1][3]);
          pf[g][s2] = __builtin_bit_cast(bf16x8, pk); }
      }
    }
    {
      bf16x8 vfa[2], vfb[2];
#define VFLD(dst, d) _Pragma("unroll") for (int s2 = 0; s2 < 2; ++s2) { \
        const uint2 v0 = *(const uint2*)(sV + ((d) * 16 + r16) * 72 + (2 * s2) * 16 + quad * 4); \
        const uint2 v1 = *(const uint2*)(sV + ((d) * 16 + r16) * 72 + (2 * s2 + 1) * 16 + quad * 4); \
        uint4 vv = make_uint4(v0.x, v0.y, v1.x, v1.y); dst[s2] = __builtin_bit_cast(bf16x8, vv); }
#define VFMM(src, d) _Pragma("unroll") for (int s2 = 0; s2 < 2; ++s2) { oacc[0][d] = MFMA16(src[s2], pf[0][s2], oacc[0][d]); oacc[1][d] = MFMA16(src[s2], pf[1][s2], oacc[1][d]); }
      VFLD(vfa, 0)
      __builtin_amdgcn_sched_barrier(0);
      VFLD(vfb, 1) VFMM(vfa, 0)
      __builtin_amdgcn_sched_barrier(0);
      VFLD(vfa, 2) VFMM(vfb, 1)
      __builtin_amdgcn_sched_barrier(0);
      VFLD(vfb, 3) VFMM(vfa, 2)
      __builtin_amdgcn_sched_barrier(0);
      VFLD(vfa, 4) VFMM(vfb, 3)
      __builtin_amdgcn_sched_barrier(0);
      VFLD(vfb, 5) VFMM(vfa, 4)
      __builtin_amdgcn_sched_barrier(0);
      VFLD(vfa, 6) VFMM(vfb, 5)
      __builtin_amdgcn_sched_barrier(0);
      VFLD(vfb, 7) VFMM(vfa, 6)
      __builtin_amdgcn_sched_barrier(0);
      VFMM(vfb, 7)
      __builtin_amdgcn_sched_barrier(0);
    }
    if (kt + 1 < S / 64) {
      sK = (u16*)smem + ((kt + 1) & 1) * 22528;
      sV = sK + 64 * 208;
      KST(0, rk0) KST(1, rk1) KST(2, rk2)
      VST(0, rv0) VST(1, rv1)
    }
    __syncthreads();
    if (kt + 2 < S / 64) {
      const u16* kn = Kg + (size_t)(kt + 2) * 64 * 192;
      const int ko = (kt + 2) * 64;
      rk0 = KLD(0, kn); rk1 = KLD(1, kn); rk2 = KLD(2, kn);
      rv0 = VLD(0, ko); rv1 = VLD(1, ko);
    }
  }
#pragma unroll
  for (int g = 0; g < 2; ++g) {
    const float l = xsum32(xsum16(l_run[g]));
    const float inv = 1.f / l;
    const int t = tq0 + g * 16 + r16;
    u16* op = OP + (size_t)t * 512 + h * 128 + quad * 8;
#pragma unroll
    for (int e = 0; e < 4; ++e) {
      const f32x4 v0 = oacc[g][2 * e] * inv, v1 = oacc[g][2 * e + 1] * inv;
      uint4 o; o.x = pack2(v0[0], v0[1]); o.y = pack2(v0[2], v0[3]); o.z = pack2(v1[0], v1[1]); o.w = pack2(v1[2], v1[3]);
      *(uint4*)(op + e * 32) = o;
    }
  }
}

DI float shift3(u16 zc, u16 zp, u16 zn, float m0, float m1) {
  const float c = bf2f(zc);
  return c + m0 * (bf2f(zp) - c) + m1 * (bf2f(zn) - c);
}
typedef float f32x2 __attribute__((ext_vector_type(2)));
DI void scan_item(const Params& p, int l, int item, char* smem) {
  const int tid = otid(), lane = tid & 63, wave = tid >> 6;
  const int dir = item & 1, bh = item >> 1, b = bh >> 3, h = bh & 7;
  float* sBase = (float*)smem;
  float* sYb = sBase + 2 * 6144;
  float* sTot = sYb + 2 * 8192;
  const u16* Z = (const u16*)(p.ws + WS_ZRKV);
  const u16* Ad = (const u16*)(p.ws + (dir ? WS_AB : WS_AF));
  const u16* Ed = (const u16*)(p.ws + (dir ? WS_EB : WS_EF));
  u16* Yd = (u16*)(p.ws + (dir ? WS_YB : WS_YF));
  constexpr int NC = S / 16;
  if (wave >= 4) {
    const int ht = tid - 256, hw = wave - 4;
    const int stl = ht >> 4, cq = ht & 15;
    const int jrow = (lane >> 4);
    const int hc = h * 64 + cq * 4;
    const float* mu0 = p.mu + (size_t)l * 2 * 1920; const float* mu1 = mu0 + 1920;
    const float4 m0r = *(const float4*)(mu0 + hc), m1r = *(const float4*)(mu1 + hc);
    const float4 m0k = *(const float4*)(mu0 + 512 + hc), m1k = *(const float4*)(mu1 + 512 + hc);
    const float4 m0v = *(const float4*)(mu0 + 1024 + hc), m1v = *(const float4*)(mu1 + 1024 + hc);
    const float4 kkw = *(const float4*)(p.k_k + l * 512 + hc), kaw = *(const float4*)(p.k_a + l * 512 + hc);
    uint2 qr0, qr1, qr2, qk0, qk1, qk2, qv0, qv1, qv2, qa, qe;
    float4 R_r, R_v, R_kd, R_b, R_nk, R_e, R_pe;
#define SCAN_PF(ci) { \
      const int step = (ci) * 16 + stl; \
      const int s_ = dir ? (S - 1 - step) : step; \
      const size_t t_ = (size_t)b * S + s_; \
      const u16* zc = Z + t_ * 1536 + hc; \
      const bool hp = s_ > 0, hn = s_ < S - 1; \
      const uint2 z2 = make_uint2(0u, 0u); \
      qr0 = *(const uint2*)zc; qk0 = *(const uint2*)(zc + 512); qv0 = *(const uint2*)(zc + 1024); \
      qr1 = hp ? *(const uint2*)(zc - 1536) : z2; qk1 = hp ? *(const uint2*)(zc + 512 - 1536) : z2; qv1 = hp ? *(const uint2*)(zc + 1024 - 1536) : z2; \
      qr2 = hn ? *(const uint2*)(zc + 1536) : z2; qk2 = hn ? *(const uint2*)(zc + 512 + 1536) : z2; qv2 = hn ? *(const uint2*)(zc + 1024 + 1536) : z2; \
      qa = *(const uint2*)(Ad + t_ * 512 + hc); qe = *(const uint2*)(Ed + t_ * 512 + hc); }
#define SH4(q0, q1, q2, m0, m1, o) { \
      float c_; \
      c_ = lo2f(q0.x); o.x = c_ + m0.x * (lo2f(q1.x) - c_) + m1.x * (lo2f(q2.x) - c_); \
      c_ = hi2f(q0.x); o.y = c_ + m0.y * (hi2f(q1.x) - c_) + m1.y * (hi2f(q2.x) - c_); \
      c_ = lo2f(q0.y); o.z = c_ + m0.z * (lo2f(q1.y) - c_) + m1.z * (lo2f(q2.y) - c_); \
      c_ = hi2f(q0.y); o.w = c_ + m0.w * (hi2f(q1.y) - c_) + m1.w * (hi2f(q2.y) - c_); }
#define UPADD(x, d) { const float t_ = __shfl_up(x, d); x += (jrow >= ((d) >> 4)) ? t_ : 0.f; }
#define SCAN_RAW(ci) { \
      float4 k4; \
      SH4(qr0, qr1, qr2, m0r, m1r, R_r) SH4(qk0, qk1, qk2, m0k, m1k, k4) SH4(qv0, qv1, qv2, m0v, m1v, R_v) \
      const float4 a4 = {lo2f(qa.x), hi2f(qa.x), lo2f(qa.y), hi2f(qa.y)}; \
      R_e = make_float4(lo2f(qe.x), hi2f(qe.x), lo2f(qe.y), hi2f(qe.y)); \
      const float4 kv = {k4.x * kkw.x, k4.y * kkw.y, k4.z * kkw.z, k4.w * kkw.w}; \
      float nrm = (kv.x * kv.x + kv.y * kv.y) + (kv.z * kv.z + kv.w * kv.w); \
      nrm = red8(nrm); nrm += dpp_f<0x140>(nrm);        \
      const float rn = rsqrtf(nrm + 1e-12f); \
      const float4 kk = {kv.x * rn, kv.y * rn, kv.z * rn, kv.w * rn}; \
      R_b = make_float4(kk.x * a4.x, kk.y * a4.y, kk.z * a4.z, kk.w * a4.w); \
      R_nk = make_float4(-kk.x, -kk.y, -kk.z, -kk.w); \
      R_kd = make_float4(k4.x * (1.f + (a4.x - 1.f) * kaw.x), k4.y * (1.f + (a4.y - 1.f) * kaw.y), k4.z * (1.f + (a4.z - 1.f) * kaw.z), k4.w * (1.f + (a4.w - 1.f) * kaw.w)); \
      R_pe = R_e;                                       \
      UPADD(R_pe.x, 16) UPADD(R_pe.y, 16) UPADD(R_pe.z, 16) UPADD(R_pe.w, 16) \
      UPADD(R_pe.x, 32) UPADD(R_pe.y, 32) UPADD(R_pe.z, 32) UPADD(R_pe.w, 32) \
      if (jrow == 3) *(float4*)(sTot + ((ci) & 1) * 256 + hw * 64 + cq * 4) = R_pe; }
#define SCAN_FIN(ci) { \
      float4 base = make_float4(0.f, 0.f, 0.f, 0.f); \
      _Pragma("unroll") for (int w_ = 0; w_ < 3; ++w_) if (w_ < hw) { \
        const float4 t4 = *(const float4*)(sTot + ((ci) & 1) * 256 + w_ * 64 + cq * 4); \
        base.x += t4.x; base.y += t4.y; base.z += t4.z; base.w += t4.w; } \
      const float4 pe = {R_pe.x + base.x, R_pe.y + base.y, R_pe.z + base.z, R_pe.w + base.w}; \
      const float4 Pt = {__expf(-pe.x), __expf(-pe.y), __expf(-pe.z), __expf(-pe.w)}; \
      const float4 Pp = {__expf(R_e.x - pe.x), __expf(R_e.y - pe.y), __expf(R_e.z - pe.z), __expf(R_e.w - pe.w)}; \
      const float4 Pi = {__expf(pe.x), __expf(pe.y), __expf(pe.z), __expf(pe.w)}; \
      float* sb_ = sBase + ((ci) & 1) * 6144 + stl * 64 + cq * 4; \
      *(float4*)(sb_) = Pt; \
      *(float4*)(sb_ + 1024) = make_float4(R_b.x * Pi.x, R_b.y * Pi.y, R_b.z * Pi.z, R_b.w * Pi.w); \
      *(float4*)(sb_ + 2048) = make_float4(R_nk.x * Pp.x, R_nk.y * Pp.y, R_nk.z * Pp.z, R_nk.w * Pp.w); \
      *(float4*)(sb_ + 3072) = make_float4(R_kd.x * Pi.x, R_kd.y * Pi.y, R_kd.z * Pi.z, R_kd.w * Pi.w); \
      *(float4*)(sb_ + 4096) = make_float4(R_r.x * Pt.x, R_r.y * Pt.y, R_r.z * Pt.z, R_r.w * Pt.w); \
      *(float4*)(sb_ + 5120) = R_v; }
#define SCAN_YOUT(ci) { \
      const int tl = ht >> 4, sl0 = (ht & 15) * 2; \
      const int step = (ci) * 16 + tl; \
      const int s_ = dir ? (S - 1 - step) : step; \
      const float* yp = sYb + ((ci) & 1) * 8192 + (tl * 32 + sl0) * 16; \
      float yo[4]; \
      _Pragma("unroll") for (int rr = 0; rr < 4; ++rr) { \
        const float4 ya_ = *(const float4*)(yp + rr * 8), yb_ = *(const float4*)(yp + rr * 8 + 4); \
        yo[rr] = ((ya_.x + ya_.y) + (ya_.z + ya_.w)) + ((yb_.x + yb_.y) + (yb_.z + yb_.w)); } \
      uint2 o; o.x = pack2(yo[0], yo[1]); o.y = pack2(yo[2], yo[3]); \
      *(uint2*)(Yd + ((size_t)b * S + s_) * 512 + h * 64 + sl0 * 2) = o; }
    SCAN_PF(0)
    SCAN_RAW(0)
    SCAN_PF(1)
    __syncthreads();
    SCAN_FIN(0)
    SCAN_RAW(1)
    SCAN_PF(2)
    __syncthreads();
    for (int ci = 0; ci < NC; ++ci) {
      if (ci + 1 < NC) {
        SCAN_FIN(ci + 1)
        if (ci + 2 < NC) {
          SCAN_RAW(ci + 2)
          if (ci + 3 < NC) SCAN_PF(ci + 3)
        }
      }
      if (ci > 0) SCAN_YOUT(ci - 1)
      __syncthreads();
    }
    SCAN_YOUT(NC - 1)
  } else {
    f32x2 a0 = {0.f, 0.f}, a1 = {0.f, 0.f}, a2 = {0.f, 0.f}, a3 = {0.f, 0.f};
    f32x2 b0 = {0.f, 0.f}, b1 = {0.f, 0.f}, b2 = {0.f, 0.f}, b3 = {0.f, 0.f};
    const int slot = wave * 8 + (lane >> 3), kq = lane & 7;
    struct VS { float4 e0, e1, n0, n1, k0, k1, r0, r1; float2 vv; };
#define SC_LOAD(X, tl) { const float* q = sb + (tl) * 64; \
      X.e0 = *(const float4*)(q + 1024); X.e1 = *(const float4*)(q + 1024 + 4); \
      X.n0 = *(const float4*)(q + 2048); X.n1 = *(const float4*)(q + 2048 + 4); \
      X.k0 = *(const float4*)(q + 3072); X.k1 = *(const float4*)(q + 3072 + 4); \
      X.r0 = *(const float4*)(q + 4096); X.r1 = *(const float4*)(q + 4096 + 4); \
      X.vv = *(const float2*)(sv + (tl) * 64); }
#define SC_STEP2(X, tl, HASP) { \
      const f32x2 nA = {X.n0.x, X.n0.y}, nB = {X.n0.z, X.n0.w}, nC = {X.n1.x, X.n1.y}, nD = {X.n1.z, X.n1.w}; \
      f32x2 sA = a0 * nA + a1 * nB; sA += a2 * nC; sA += a3 * nD; \
      f32x2 sB = b0 * nA + b1 * nB; sB += b2 * nC; sB += b3 * nD; \
      f32x2 yA = {0.f, 0.f}, yB = {0.f, 0.f}; \
      if (HASP) { \
        const f32x2 rA = {pr0.x, pr0.y}, rB = {pr0.z, pr0.w}, rC = {pr1.x, pr1.y}, rD = {pr1.z, pr1.w}; \
        yA = a0 * rA + a1 * rB; yA += a2 * rC; yA += a3 * rD; \
        yB = b0 * rA + b1 * rB; yB += b2 * rC; yB += b3 * rD; } \
      const float saA = red8(sA.x + sA.y), saB = red8(sB.x + sB.y); \
      if (HASP) { sy[((tl) - 1) * 512] = yA.x + yA.y; sy[((tl) - 1) * 512 + 8] = yB.x + yB.y; } \
      const f32x2 sav = {saA, saA}, sbv = {saB, saB}, va = {X.vv.x, X.vv.x}, vb = {X.vv.y, X.vv.y}; \
      const f32x2 eA = {X.e0.x, X.e0.y}, eB = {X.e0.z, X.e0.w}, eC = {X.e1.x, X.e1.y}, eD = {X.e1.z, X.e1.w}; \
      const f32x2 kA = {X.k0.x, X.k0.y}, kB = {X.k0.z, X.k0.w}, kC = {X.k1.x, X.k1.y}, kD = {X.k1.z, X.k1.w}; \
      a0 += va * kA; a1 += va * kB; a2 += va * kC; a3 += va * kD; \
      b0 += vb * kA; b1 += vb * kB; b2 += vb * kC; b3 += vb * kD; \
      a0 += sav * eA; a1 += sav * eB; a2 += sav * eC; a3 += sav * eD; \
      b0 += sbv * eA; b1 += sbv * eB; b2 += sbv * eC; b3 += sbv * eD; \
      pr0 = X.r0; pr1 = X.r1; }
    __syncthreads();
    __syncthreads();
    for (int ci = 0; ci < NC; ++ci) {
      const float* sb = sBase + (ci & 1) * 6144 + kq * 8;
      const float* sv = sBase + (ci & 1) * 6144 + 5120 + slot * 2;
      float* sy = sYb + (ci & 1) * 8192 + slot * 16 + kq;
      VS Q[3];
      float4 pr0, pr1;
      SC_LOAD(Q[0], 0)
      SC_LOAD(Q[1], 1)
      SC_LOAD(Q[2], 2)
      SC_STEP2(Q[0], 0, false)
#pragma unroll
      for (int tl = 1; tl < 16; ++tl) {
        if (tl + 2 < 16) SC_LOAD(Q[(tl + 2) % 3], tl + 2)
        SC_STEP2(Q[tl % 3], tl, true)
      }
      {
        const f32x2 rA = {pr0.x, pr0.y}, rB = {pr0.z, pr0.w}, rC = {pr1.x, pr1.y}, rD = {pr1.z, pr1.w};
        f32x2 yA = a0 * rA + a1 * rB; yA += a2 * rC; yA += a3 * rD;
        f32x2 yB = b0 * rA + b1 * rB; yB += b2 * rC; yB += b3 * rD;
        sy[15 * 512] = yA.x + yA.y; sy[15 * 512 + 8] = yB.x + yB.y;
        const float4 p0 = *(const float4*)(sb + 15 * 64), p1 = *(const float4*)(sb + 15 * 64 + 4);
        const f32x2 pA = {p0.x, p0.y}, pB = {p0.z, p0.w}, pC = {p1.x, p1.y}, pD = {p1.z, p1.w};
        a0 *= pA; a1 *= pB; a2 *= pC; a3 *= pD;
        b0 *= pA; b1 *= pB; b2 *= pC; b3 *= pD;
      }
      __syncthreads();
    }
  }
}

DI void unpack8(const uint4 q, float (&f)[8]) {
  f[0] = lo2f(q.x); f[1] = hi2f(q.x); f[2] = lo2f(q.y); f[3] = hi2f(q.y); f[4] = lo2f(q.z); f[5] = hi2f(q.z); f[6] = lo2f(q.w); f[7] = hi2f(q.w);
}
DI void load8f(const float* p, float (&f)[8]) {
  const float4 a = *(const float4*)p, b = *(const float4*)(p + 4);
  f[0] = a.x; f[1] = a.y; f[2] = a.z; f[3] = a.w; f[4] = b.x; f[5] = b.y; f[6] = b.z; f[7] = b.w;
}
DI void rwkv_out_phase(const Params& p, int l) {
  const u16* Z = (const u16*)(p.ws + WS_ZRKV);
  const u16* AF = (const u16*)(p.ws + WS_AF); const u16* AB = (const u16*)(p.ws + WS_AB); const u16* GG = (const u16*)(p.ws + WS_GG);
  const u16* YF = (const u16*)(p.ws + WS_YF); const u16* YB = (const u16*)(p.ws + WS_YB);
  u16* CC = (u16*)(p.ws + WS_CC);
  const float* mu0 = p.mu + (size_t)l * 2 * 1920; const float* mu1 = mu0 + 1920;
  const int tid_ = otid(); const int lane = tid_ & 63;
  const int gw = (blockIdx.x * NTHR + tid_) >> 6, nw = (gridDim.x * NTHR) >> 6;
  const int c0 = lane * 8;
  for (int t = gw; t < T; t += nw) {
    const int s = t & (S - 1);
    const bool hp = s > 0, hn = s < S - 1;
    const u16* zc = Z + (size_t)t * 1536 + c0;
    const uint4 z0 = make_uint4(0, 0, 0, 0);
    const uint4 qr = *(const uint4*)zc, qk = *(const uint4*)(zc + 512), qv = *(const uint4*)(zc + 1024);
    const uint4 pr = hp ? *(const uint4*)(zc - 1536) : z0, pk = hp ? *(const uint4*)(zc + 512 - 1536) : z0, pv = hp ? *(const uint4*)(zc + 1024 - 1536) : z0;
    const uint4 nr = hn ? *(const uint4*)(zc + 1536) : z0, nk = hn ? *(const uint4*)(zc + 512 + 1536) : z0, nv = hn ? *(const uint4*)(zc + 1024 + 1536) : z0;
    const size_t o = (size_t)t * 512 + c0;
    const uint4 qaf = *(const uint4*)(AF + o), qab = *(const uint4*)(AB + o), qg = *(const uint4*)(GG + o);
    const uint4 qyf = *(const uint4*)(YF + o), qyb = *(const uint4*)(YB + o);
    float r[8], k[8], v[8], tp[8], tn[8], ma[8], mb[8];
    unpack8(qr, r); unpack8(pr, tp); unpack8(nr, tn); load8f(mu0 + c0, ma); load8f(mu1 + c0, mb);
#pragma unroll
    for (int j = 0; j < 8; ++j) r[j] = r[j] + ma[j] * (tp[j] - r[j]) + mb[j] * (tn[j] - r[j]);
    unpack8(qk, k); unpack8(pk, tp); unpack8(nk, tn); load8f(mu0 + 512 + c0, ma); load8f(mu1 + 512 + c0, mb);
#pragma unroll
    for (int j = 0; j < 8; ++j) k[j] = k[j] + ma[j] * (tp[j] - k[j]) + mb[j] * (tn[j] - k[j]);
    unpack8(qv, v); unpack8(pv, tp); unpack8(nv, tn); load8f(mu0 + 1024 + c0, ma); load8f(mu1 + 1024 + c0, mb);
#pragma unroll
    for (int j = 0; j < 8; ++j) v[j] = v[j] + ma[j] * (tp[j] - v[j]) + mb[j] * (tn[j] - v[j]);
    float af[8], ab[8], y[8], yb[8], ka[8], rk[8];
    unpack8(qaf, af); unpack8(qab, ab); unpack8(qyf, y); unpack8(qyb, yb);
    load8f(p.k_a + l * 512 + c0, ka); load8f(p.r_k + l * 512 + c0, rk);
    float sy = 0.f, sb = 0.f;
#pragma unroll
    for (int j = 0; j < 8; ++j) {
      y[j] += yb[j]; sy += y[j];
      const float kb = k[j] * (1.f + (0.5f * (af[j] + ab[j]) - 1.f) * ka[j]);
      sb += r[j] * kb * rk[j];
    }
    const float mean = red8(sy) * (1.f / 64.f);
    const float bs = red8(sb);
    float sv = 0.f;
#pragma unroll
    for (int j = 0; j < 8; ++j) { y[j] -= mean; sv += y[j] * y[j]; }
    const float rstd = rsqrtf(red8(sv) * (1.f / 64.f) + 64e-5f);
    float g[8], gg[8], gb[8];
    unpack8(qg, g); load8f(p.gn_g + l * 512 + c0, gg); load8f(p.gn_b + l * 512 + c0, gb);
    float ov[8];
#pragma unroll
    for (int j = 0; j < 8; ++j) ov[j] = (y[j] * rstd * gg[j] + gb[j] + bs * v[j]) * g[j];
    uint4 oo; oo.x = pack2(ov[0], ov[1]); oo.y = pack2(ov[2], ov[3]); oo.z = pack2(ov[4], ov[5]); oo.w = pack2(ov[6], ov[7]);
    *(uint4*)(CC + (size_t)t * 1024 + 512 + c0) = oo;
  }
}

DI void conv_phase(const Params& p, int l) {
  const u16* G = (const u16*)(p.ws + WS_G);
  u16* GS = (u16*)(p.ws + WS_ACT);
  const float* cw = p.conv_w + (size_t)l * 3 * DFF; const float* cb = p.conv_b + (size_t)l * DFF;
  const int tid_ = otid();
  constexpr int RUN = 16;
  const int nitems = (T / RUN) * (DFF / 8);
  for (int it = blockIdx.x * NTHR + tid_; it < nitems; it += gridDim.x * NTHR) {
    const int rr = it / (DFF / 8), cg = it - rr * (DFF / 8);
    const int t0 = rr * RUN, c0 = cg * 8;
    const u16* gp = G + (size_t)t0 * DFF + c0;
    const int s0 = t0 & (S - 1);
    uint4 rows[RUN + 2];
    const uint4 z = make_uint4(0, 0, 0, 0);
    rows[0] = (s0 > 0) ? *(const uint4*)(gp - DFF) : z;
#pragma unroll
    for (int i = 0; i < RUN; ++i) rows[i + 1] = *(const uint4*)(gp + (size_t)i * DFF);
    rows[RUN + 1] = (s0 + RUN - 1 < S - 1) ? *(const uint4*)(gp + (size_t)RUN * DFF) : z;
    float w0[8], w1[8], w2[8], bb[8];
    load8f(cw + c0, w0); load8f(cw + DFF + c0, w1); load8f(cw + 2 * DFF + c0, w2); load8f(cb + c0, bb);
    float prev[8], cur[8], nxt[8];
    unpack8(rows[0], prev); unpack8(rows[1], cur);
#pragma unroll
    for (int i = 0; i < RUN; ++i) {
      unpack8(rows[i + 2], nxt);
      float o[8];
#pragma unroll
      for (int j = 0; j < 8; ++j) { const float g = w0[j] * prev[j] + w1[j] * cur[j] + w2[j] * nxt[j] + bb[j]; o[j] = g * sigmoidf_(g); }
      uint4 oo; oo.x = pack2(o[0], o[1]); oo.y = pack2(o[2], o[3]); oo.z = pack2(o[4], o[5]); oo.w = pack2(o[6], o[7]);
      *(uint4*)(GS + (size_t)(t0 + i) * DFF + c0) = oo;
#pragma unroll
      for (int j = 0; j < 8; ++j) { prev[j] = cur[j]; cur[j] = nxt[j]; }
    }
  }
}

DI void mla_out_phase(const Params& p, int l) {
  const u16* OO = (const u16*)(p.ws + WS_OO);
  u16* CC = (u16*)(p.ws + WS_CC);
  const int tid_ = otid(); const int lane = tid_ & 63;
  const int gw = (blockIdx.x * NTHR + tid_) >> 6, nw = (gridDim.x * NTHR) >> 6;
  const float* on = p.out_norm + l * 512 + lane * 8;
  const float4 w0 = *(const float4*)on, w1 = *(const float4*)(on + 4);
  for (int t = gw; t < T; t += nw) {
    const uint4 q = *(const uint4*)(OO + (size_t)t * 512 + lane * 8);
    float v[8] = {lo2f(q.x), hi2f(q.x), lo2f(q.y), hi2f(q.y), lo2f(q.z), hi2f(q.z), lo2f(q.w), hi2f(q.w)};
    float ss = 0.f;
#pragma unroll
    for (int i = 0; i < 8; ++i) ss += v[i] * v[i];
    ss = wave_sum(ss);
    const float rstd = rsqrtf(ss * (1.f / 512.f) + 1e-6f);
    uint4 o;
    o.x = pack2(v[0] * rstd * w0.x, v[1] * rstd * w0.y); o.y = pack2(v[2] * rstd * w0.z, v[3] * rstd * w0.w);
    o.z = pack2(v[4] * rstd * w1.x, v[5] * rstd * w1.y); o.w = pack2(v[6] * rstd * w1.z, v[7] * rstd * w1.w);
    *(uint4*)(CC + (size_t)t * 1024 + lane * 8) = o;
  }
}

DI void phase0(const Params& p, char* smem) {
  const int tid = otid(), lane = tid & 63, wave = tid >> 6;
  if (blockIdx.x < 384) {
    float* sc = (float*)smem;
    float* red = sc + 8192;
    for (int i = tid; i < 8192; i += NTHR) { const float cv = p.c[i]; sc[i] = cv / (1.f + __expf(-cv)); }
    __syncthreads();
    float* MOD = (float*)(p.ws + WS_MOD);
    for (int it = blockIdx.x; it < 384; it += gridDim.x) {
      const int l = it / 96, cg = it - l * 96;
      const int j = cg * 64 + lane;
      const float* wp = p.ada_w + (size_t)l * 1024 * 6144 + (size_t)(wave * 128) * 6144 + j;
      float acc[8];
#pragma unroll
      for (int bb = 0; bb < 8; ++bb) acc[bb] = 0.f;
#pragma unroll 8
      for (int i = 0; i < 128; ++i) {
        const float wv = wp[(size_t)i * 6144];
#pragma unroll
        for (int bb = 0; bb < 8; ++bb) acc[bb] += sc[bb * 1024 + wave * 128 + i] * wv;
      }
#pragma unroll
      for (int bb = 0; bb < 8; ++bb) red[(wave * 8 + bb) * 64 + lane] = acc[bb];
      __syncthreads();
      {
        const int bb = tid >> 6, jl = tid & 63;
        float v = 0.f;
#pragma unroll
        for (int w = 0; w < 8; ++w) v += red[(w * 8 + bb) * 64 + jl];
        MOD[((size_t)l * 8 + bb) * 6144 + cg * 64 + jl] = v + p.ada_b[l * 6144 + cg * 64 + jl];
      }
      __syncthreads();
    }
  }
  __syncthreads();
  {
    u16* WQ = (u16*)(p.ws + WS_WQ);
    const int total = NLAYER * 768 * 256;
    for (int id = blockIdx.x * NTHR + tid; id < total; id += gridDim.x * NTHR) {
      const int i = id & 255, n = (id >> 8) % 768, l = id / (768 * 256);
      const int h = n / 192, j = n - h * 192;
      const float* uq = p.w_uq + (size_t)l * 256 * 768 + (size_t)i * 768 + h * 192;
      float v;
      if (j < 128) {
        const float* uk = p.w_ukv + (size_t)l * 128 * 1024 + (size_t)j * 1024 + h * 256;
        float a0 = 0.f, a1 = 0.f, a2 = 0.f, a3 = 0.f;
        for (int d = 0; d < 128; d += 4) {
          const float4 x = *(const float4*)(uq + d), y = *(const float4*)(uk + d);
          a0 += x.x * y.x; a1 += x.y * y.y; a2 += x.z * y.z; a3 += x.w * y.w;
        }
        v = (a0 + a1) + (a2 + a3);
      } else v = uq[j];
      WQ[id] = f2bf(v);
    }
  }
  {
    u16* WIN = (u16*)(p.ws + WS_WIN);
    const int per = (DINP - DIN) * 1024 / 8;
    for (int id = blockIdx.x * NTHR + tid; id < NLAYER * per; id += gridDim.x * NTHR) {
      const int l = id / per, r = id - l * per;
      *(uint4*)(WIN + (size_t)l * DINP * 1024 + (size_t)DIN * 1024 + (size_t)r * 8) = make_uint4(0, 0, 0, 0);
    }
  }
  int rot = 0;
  for (int l = 0; l < NLAYER; ++l) {
    tr_phase(p.w_up + (size_t)l * 1024 * 5632, 5632, 1024, 5632, (u16*)(p.ws + WS_WUP) + (size_t)l * 5632 * 1024, smem, rot);
    tr_phase(p.w_down + (size_t)l * 2816 * 1024, 1024, 2816, 1024, (u16*)(p.ws + WS_WDN) + (size_t)l * 1024 * 2816, smem, rot);
    tr_phase(p.w_in + (size_t)l * 1024 * DIN, DIN, 1024, DIN, (u16*)(p.ws + WS_WIN) + (size_t)l * DINP * 1024, smem, rot);
    tr_phase(p.w_out + (size_t)l * 1024 * 1024, 1024, 1024, 1024, (u16*)(p.ws + WS_WOUT) + (size_t)l * 1024 * 1024, smem, rot);
    tr_phase(p.w_ukv + (size_t)l * 128 * 1024, 1024, 128, 1024, (u16*)(p.ws + WS_WUKV) + (size_t)l * 1024 * 128, smem, rot);
    tr_phase(p.g2 + (size_t)l * 128 * 512, 512, 128, 512, (u16*)(p.ws + WS_G2) + (size_t)l * 512 * 128, smem, rot);
    for (int d = 0; d < 2; ++d) {
      tr_phase(p.w2 + (size_t)(l * 2 + d) * 64 * 512, 512, 64, 512, (u16*)(p.ws + WS_W2) + (size_t)(l * 2 + d) * 512 * 64, smem, rot);
      tr_phase(p.a2 + (size_t)(l * 2 + d) * 64 * 512, 512, 64, 512, (u16*)(p.ws + WS_A2) + (size_t)(l * 2 + d) * 512 * 64, smem, rot);
    }
  }
}

#define XB_TMO      128
#define XB_XCNT(j)  (256  + 64 * (j))
#define XB_XSUB(j)  (1280 + 64 * (j))
#define XB_XGEN(j)  (2304 + 64 * (j))
#define XB_TOP      3328
#define XB_TOPGEN   3392
#define XCD_BAR_WORDS 3456
#define XB_SPIN_CAP (1u << 22)
#define LAS __attribute__((address_space(3)))

__device__ __forceinline__ unsigned xb_ld(unsigned* p)              { return __hip_atomic_load(p, __ATOMIC_RELAXED, __HIP_MEMORY_SCOPE_AGENT); }
__device__ __forceinline__ unsigned xb_add(unsigned* p, unsigned v) { return __hip_atomic_fetch_add(p, v, __ATOMIC_RELAXED, __HIP_MEMORY_SCOPE_AGENT); }
__device__ __forceinline__ unsigned xb_xcc_id() { return (unsigned)__builtin_amdgcn_s_getreg((3 << 11) | 20) & 0xFu; }
#define XB_SPIN(cond, bar) do { unsigned _sp = 0; while (cond) { __builtin_amdgcn_s_sleep(1); \
    if ((++_sp & 255u) == 0u) { if (xb_ld(&(bar)[XB_TMO])) break; if (_sp > XB_SPIN_CAP) { atomicAdd(&(bar)[XB_TMO], 1u); break; } } } } while (0)

struct XcdBarrier {
    unsigned* bar; unsigned x;
    volatile LAS unsigned* st;
};

__device__ __forceinline__ XcdBarrier xcd_barrier_post(unsigned* bar, volatile LAS unsigned* st) {
    XcdBarrier b; b.bar = bar; b.x = xb_xcc_id(); b.st = st;
    if (threadIdx.x == 0) (void)xb_add(&bar[XB_XCNT(b.x)], 1u);
    return b;
}
__device__ __forceinline__ void xcd_barrier_complete(unsigned* bar, unsigned x, unsigned& nloc, unsigned& nx) {
    const unsigned G = gridDim.x * gridDim.y * gridDim.z;
    unsigned sum, cnt, mine, sp = 0u;
    for (;;) {
        sum = 0u; cnt = 0u; mine = 0u;
#pragma unroll
        for (unsigned j = 0; j < 16; ++j) { const unsigned c = xb_ld(&bar[XB_XCNT(j)]); sum += c; cnt += (c > 0u) ? 1u : 0u; mine = (j == x) ? c : mine; }
        if (sum == G) break;
        __builtin_amdgcn_s_sleep(1);
        if ((++sp & 255u) == 0u) { if (xb_ld(&bar[XB_TMO])) break; if (sp > XB_SPIN_CAP) { atomicAdd(&bar[XB_TMO], 1u); break; } }
    }
    nloc = mine > 0u ? mine : 1u; nx = cnt > 0u ? cnt : 1u;
}

__device__ __forceinline__ void xcd_barrier(const XcdBarrier& b) {
    asm volatile("s_waitcnt vmcnt(0)" ::: "memory");
    __syncthreads();
    if (threadIdx.x == 0) {
        unsigned* bar = b.bar;
        __builtin_amdgcn_s_waitcnt(0);
        unsigned nloc = b.st[0], nx = b.st[1];
        if (nloc == 0u) { xcd_barrier_complete(bar, b.x, nloc, nx); b.st[0] = nloc; b.st[1] = nx; }
        const unsigned old = xb_add(&bar[XB_XSUB(b.x)], 1u);
        const unsigned gen = old / nloc;
        if (old + 1u == (gen + 1u) * nloc) {
            __builtin_amdgcn_fence(__ATOMIC_RELEASE, "agent");
            asm volatile("s_waitcnt vmcnt(0)" ::: "memory");
            const unsigned og = xb_add(&bar[XB_TOP], 1u);
            const unsigned tg = og / nx;
            if (og + 1u == (tg + 1u) * nx) xb_add(&bar[XB_TOPGEN], 1u);
            else XB_SPIN(xb_ld(&bar[XB_TOPGEN]) == tg, bar);
            __builtin_amdgcn_fence(__ATOMIC_ACQUIRE, "agent");
            xb_add(&bar[XB_XGEN(b.x)], 1u);
            asm volatile("s_waitcnt vmcnt(0)" ::: "memory");
        } else {
            XB_SPIN(xb_ld(&bar[XB_XGEN(b.x)]) == gen, bar);
            __builtin_amdgcn_fence(__ATOMIC_ACQUIRE, "agent");
            asm volatile("s_waitcnt vmcnt(0)" ::: "memory");
        }
    }
    __syncthreads();
}

__global__ void __launch_bounds__(512) fwd_megakernel(Params p) {
  cg::grid_group grid = cg::this_grid();
  extern __shared__ __attribute__((aligned(16))) char smem[];
  int& s_item = *(int*)(smem + 131072);
  const int tid = threadIdx.x;
  if (tid == 0) *(uint4*)(smem + 131072 + 16) = make_uint4(0u, 0u, 0u, 0u);
  __syncthreads();
  XcdBarrier xb = xcd_barrier_post((unsigned*)(p.ws + WS_BAR), (volatile LAS unsigned*)(smem + 131072 + 16));
  int* counters = (int*)(p.ws + WS_CNT);
  const float* MOD = (const float*)(p.ws + WS_MOD);
  u16* H = (u16*)(p.ws + WS_H);

  phase0(p, smem);
  grid.sync();

  for (int sg = 0; sg < NLAYER * 6; ++sg) {
    const int l = sg / 6, q = sg - l * 6;
    const float* Xin = (l == 0) ? p.x : p.out;
    float* X = p.out;
    const float* modl = MOD + (size_t)l * 8 * 6144;
    if (q == 0) {
      norm_mod_phase(Xin, modl, 0, 1024, H);
      xcd_barrier(xb);
    } else if (q == 1) {
      prep_phase(p, l);
      xcd_barrier(xb);
      int rot = 0;
      {
        const u16* LA = (const u16*)(p.ws + WS_LA);
        u16* GG = (u16*)(p.ws + WS_GG);
        gemm_small(LA + 256, 384, (const u16*)(p.ws + WS_G2) + (size_t)l * 512 * 128, 128, 512, 128, GG, 512,
                   [=](int n, f32x4 v) { return v; }, smem, rot);
        for (int d = 0; d < 2; ++d) {
          u16* AO = (u16*)(p.ws + (d ? WS_AB : WS_AF));
          const float* a0 = p.a0 + (size_t)(l * 2 + d) * 512;
          gemm_small(LA + 128 + 64 * d, 384, (const u16*)(p.ws + WS_A2) + (size_t)(l * 2 + d) * 512 * 64, 64, 512, 64, AO, 512,
                     [=](int n, f32x4 v) {
                       const float4 b = *(const float4*)(a0 + n);
                       f32x4 o = {sigmoidf_(v[0] + b.x), sigmoidf_(v[1] + b.y), sigmoidf_(v[2] + b.z), sigmoidf_(v[3] + b.w)};
                       return o;
                     }, smem, rot);
          u16* EO = (u16*)(p.ws + (d ? WS_EB : WS_EF));
          const float* w0 = p.w0 + (size_t)(l * 2 + d) * 512;
          gemm_small(LA + 64 * d, 384, (const u16*)(p.ws + WS_W2) + (size_t)(l * 2 + d) * 512 * 64, 64, 512, 64, EO, 512,
                     [=](int n, f32x4 v) {
                       const float4 b = *(const float4*)(w0 + n);
                       const float ce = 0.6065306597126334f;
                       f32x4 o = {ce * sigmoidf_(v[0] + b.x), ce * sigmoidf_(v[1] + b.y), ce * sigmoidf_(v[2] + b.z), ce * sigmoidf_(v[3] + b.w)};
                       return o;
                     }, smem, rot);
        }
      }
          } else if (q == 2) {
      int rot = 0;
      while (true) {
        __syncthreads();
        if (tid == 0) s_item = atomicAdd(&counters[l], 1);
        __syncthreads();
        const int item = s_item;
        if (item >= 128 + 1024) break;
#ifndef NO_SCAN
        if (item < 128) scan_item(p, l, item, smem);
#endif
#ifndef NO_ATTN
        if (item >= 128) attn_item(p, item - 128, smem);
#endif
      }
      xcd_barrier(xb);
      {
        const u16* OP = (const u16*)(p.ws + WS_OP); u16* OO = (u16*)(p.ws + WS_OO);
        for (int h = 0; h < 4; ++h) {
          gemm_small(OP + h * 128, 512, (const u16*)(p.ws + WS_WUKV) + (size_t)l * 1024 * 128 + (size_t)(h * 256 + 128) * 128, 128, 128, 128, OO + h * 128, 512,
                     [=](int n, f32x4 v) { return v; }, smem, rot);
        }
        rwkv_out_phase(p, l);
      }
      xcd_barrier(xb);
      mla_out_phase(p, l);
      xcd_barrier(xb);
    } else if (q == 3) {
      norm_mod_phase(X, modl, 3072, 4096, H);
      xcd_barrier(xb);
    } else if (q == 4) {
      conv_phase(p, l);
      xcd_barrier(xb);
    }
    {
      u16* G = (u16*)(p.ws + WS_G); u16* ACT = (u16*)(p.ws + WS_ACT);
      const u16* A = H; const u16* Bt; int Npad, K = 1024;
      BigEpi E{};
      if (q == 0) {
        Bt = (const u16*)(p.ws + WS_WIN) + (size_t)l * DINP * 1024; Npad = DINP;
        E.mode = 0; E.N = DIN; E.o0 = (u16*)(p.ws + WS_ZREST); E.o1 = (u16*)(p.ws + WS_ZRKV);
      } else if (q == 1) {
        A = (const u16*)(p.ws + WS_QN); Bt = (const u16*)(p.ws + WS_WQ) + (size_t)l * 768 * 256; Npad = 768; K = 256;
        E.mode = 1; E.N = 768; E.ld = 768; E.o0 = (u16*)(p.ws + WS_QP);
      } else if (q == 2) {
        A = (const u16*)(p.ws + WS_CC); Bt = (const u16*)(p.ws + WS_WOUT) + (size_t)l * 1024 * 1024; Npad = 1024;
        E.mode = 2; E.N = 1024; E.xin = Xin; E.xout = X; E.gate = modl + 2048;
      } else if (q == 3) {
        Bt = (const u16*)(p.ws + WS_WUP) + (size_t)l * 5632 * 1024; Npad = DFF;
        E.mode = 1; E.N = DFF; E.ld = DFF; E.o0 = G;
      } else if (q == 4) {
        Bt = (const u16*)(p.ws + WS_WUP) + (size_t)l * 5632 * 1024 + (size_t)DFF * 1024; Npad = DFF;
        E.mode = 3; E.N = DFF; E.o0 = ACT;
      } else {
        A = ACT; Bt = (const u16*)(p.ws + WS_WDN) + (size_t)l * 1024 * DFF; Npad = 1024; K = DFF;
        E.mode = 2; E.N = 1024; E.xin = X; E.xout = X; E.gate = modl + 5120;
      }
      gemm_big(smem, A, Bt, Npad, K, E);
    }
    xcd_barrier(xb);
  }
  {
    const int lane = tid & 63;
    const int gw = (blockIdx.x * NTHR + tid) >> 6, nw = (gridDim.x * NTHR) >> 6;
    for (int t = gw; t < T; t += nw) {
      float4* xr = (float4*)(p.out + (size_t)t * DM);
      float4 v[4];
      float ss = 0.f;
#pragma unroll
      for (int i = 0; i < 4; ++i) { v[i] = xr[lane + 64 * i]; ss += v[i].x * v[i].x + v[i].y * v[i].y + v[i].z * v[i].z + v[i].w * v[i].w; }
      ss = wave_sum(ss);
      const float rstd = rsqrtf(ss * (1.f / 1024.f) + 1e-6f);
#pragma unroll
      for (int i = 0; i < 4; ++i) {
        const float4 w = *(const float4*)(p.final_norm + (lane + 64 * i) * 4);
        float4 o = {v[i].x * rstd * w.x, v[i].y * rstd * w.y, v[i].z * rstd * w.z, v[i].w * rstd * w.w};
        xr[lane + 64 * i] = o;
      }
    }
  }
}

extern "C" void kernel_launch(void* const* d_in, const int* in_sizes, int n_in, void* d_out, int out_size, void* d_ws,
                              size_t ws_size, hipStream_t stream) {
  static int grid_blocks = 0;
  if (!grid_blocks) {
    int dev = 0, cus = 0, per_cu = 0;
    hipGetDevice(&dev);
    hipDeviceGetAttribute(&cus, hipDeviceAttributeMultiprocessorCount, dev);
    hipFuncSetAttribute((const void*)fwd_megakernel, hipFuncAttributeMaxDynamicSharedMemorySize, LDS_BYTES);
    hipOccupancyMaxActiveBlocksPerMultiprocessor(&per_cu, fwd_megakernel, NTHR, LDS_BYTES);
    if (per_cu > 1) per_cu = 1;
    if (per_cu < 1) per_cu = 1;
    grid_blocks = cus * per_cu;
    if (ws_size < WS_END) fprintf(stderr, "kernel_launch: workspace too small: %zu < %zu\n", ws_size, (size_t)WS_END);
  }
  Params p{};
  p.x = (const float*)d_in[0]; p.c = (const float*)d_in[1]; p.pos = (const int*)d_in[2]; p.ada_w = (const float*)d_in[3];
  p.ada_b = (const float*)d_in[4]; p.w_in = (const float*)d_in[5]; p.q_norm = (const float*)d_in[6]; p.w_uq = (const float*)d_in[7];
  p.kv_norm = (const float*)d_in[8]; p.w_ukv = (const float*)d_in[9]; p.out_norm = (const float*)d_in[10]; p.mu = (const float*)d_in[11];
  p.w0 = (const float*)d_in[12]; p.w2 = (const float*)d_in[13]; p.a0 = (const float*)d_in[14]; p.a2 = (const float*)d_in[15];
  p.g2 = (const float*)d_in[16]; p.k_k = (const float*)d_in[17]; p.k_a = (const float*)d_in[18]; p.r_k = (const float*)d_in[19];
  p.gn_g = (const float*)d_in[20]; p.gn_b = (const float*)d_in[21]; p.w_out = (const float*)d_in[22]; p.w_up = (const float*)d_in[23];
  p.conv_w = (const float*)d_in[24]; p.conv_b = (const float*)d_in[25]; p.w_down = (const float*)d_in[26]; p.final_norm = (const float*)d_in[27];
  p.out = (float*)d_out; p.ws = (unsigned char*)d_ws;
  hipMemsetAsync((char*)d_ws + WS_CNT, 0, 16384, stream);
  void* args[] = {&p};
  hipError_t e = hipLaunchCooperativeKernel((void*)fwd_megakernel, dim3(grid_blocks), dim3(NTHR), args, LDS_BYTES, stream);
  if (e != hipSuccess) fprintf(stderr, "cooperative launch failed: %s (grid %d)\n", hipGetErrorString(e), grid_blocks);
}
```

```cpp
#include <hip/hip_runtime.h>
#include <hip/hip_cooperative_groups.h>
#include <cstdio>
#include <cstdint>
namespace cg = cooperative_groups;

typedef unsigned short u16;
using bf16x8 = __attribute__((ext_vector_type(8))) short;
using f32x4 = __attribute__((ext_vector_type(4))) float;
#define DI __device__ __forceinline__

constexpr int T = 65536;
constexpr int S = 8192;
constexpr int DM = 1024;
constexpr int DFF = 2816;
constexpr int DIN = 2368;
constexpr int DINP = 2560;
constexpr int NLAYER = 4;
constexpr int NTHR = 512;
constexpr int LDS_BYTES = 131072 + 64;

constexpr size_t MB = 1ull << 20;
constexpr size_t WS_CNT = 0;
constexpr size_t WS_BAR = 1024;
constexpr size_t WS_MOD = 32768;
constexpr size_t WS_WIN = WS_MOD + 4ull * 8 * 6144 * 4;
constexpr size_t WS_WQ = WS_WIN + 4ull * DINP * 1024 * 2;
constexpr size_t WS_WUKV = WS_WQ + 4ull * 768 * 256 * 2;
constexpr size_t WS_W2 = WS_WUKV + 4ull * 1024 * 128 * 2;
constexpr size_t WS_A2 = WS_W2 + 4ull * 2 * 512 * 64 * 2;
constexpr size_t WS_G2 = WS_A2 + 4ull * 2 * 512 * 64 * 2;
constexpr size_t WS_WOUT = WS_G2 + 4ull * 512 * 128 * 2;
constexpr size_t WS_WUP = WS_WOUT + 4ull * 1024 * 1024 * 2;
constexpr size_t WS_WDN = WS_WUP + 4ull * 5632 * 1024 * 2;
constexpr size_t WS_ACT0 = ((WS_WDN + 4ull * 1024 * 2816 * 2) + 4095) & ~(size_t)4095;
constexpr size_t WS_H = WS_ACT0;
constexpr size_t WS_QN = WS_H;
constexpr size_t WS_LA = WS_H + (size_t)T * 256 * 2;
constexpr size_t WS_YF = WS_H;
constexpr size_t WS_YB = WS_H + (size_t)T * 512 * 2;
constexpr size_t WS_ZRKV = WS_H + (size_t)T * 1024 * 2;
constexpr size_t WS_ZREST = WS_ZRKV + (size_t)T * 1536 * 2;
constexpr size_t WS_OP = WS_ZREST;
constexpr size_t WS_AF = WS_ZREST + (size_t)T * 832 * 2;
constexpr size_t WS_AB = WS_AF + (size_t)T * 512 * 2;
constexpr size_t WS_GG = WS_AB + (size_t)T * 512 * 2;
constexpr size_t WS_EF = WS_GG + (size_t)T * 512 * 2;
constexpr size_t WS_EB = WS_EF + (size_t)T * 512 * 2;
constexpr size_t WS_CC = WS_EF;
constexpr size_t WS_QP = WS_EB + (size_t)T * 512 * 2;
constexpr size_t WS_OO = WS_QP;
constexpr size_t WS_KV = WS_QP + (size_t)T * 768 * 2;
constexpr size_t WS_VT = WS_KV + (size_t)T * 192 * 2;
constexpr size_t WS_END = WS_VT + (size_t)T * 128 * 2;
constexpr size_t WS_G = WS_ZRKV;
constexpr size_t WS_ACT = WS_G + (size_t)T * 2816 * 2;
static_assert(WS_ACT + (size_t)T * 2816 * 2 <= WS_END, "ffn overlay");
static_assert(WS_END <= 1073741824ull, "ws budget");

struct Params {
  const float* x; const float* c; const int* pos; const float* ada_w; const float* ada_b; const float* w_in;
  const float* q_norm; const float* w_uq; const float* kv_norm; const float* w_ukv; const float* out_norm;
  const float* mu; const float* w0; const float* w2; const float* a0; const float* a2; const float* g2;
  const float* k_k; const float* k_a; const float* r_k; const float* gn_g; const float* gn_b;
  const float* w_out; const float* w_up; const float* conv_w; const float* conv_b; const float* w_down;
  const float* final_norm;
  float* out; unsigned char* ws;
};

DI u16 f2bf(float f) { __bf16 b = (__bf16)f; return __builtin_bit_cast(u16, b); }
DI float bf2f(u16 h) { return __uint_as_float(((unsigned)h) << 16); }
typedef __bf16 bf16x2_t __attribute__((ext_vector_type(2)));
typedef float f32x2_t __attribute__((ext_vector_type(2)));
DI unsigned pack2(float a, float b) { f32x2_t v = {a, b}; bf16x2_t r = __builtin_convertvector(v, bf16x2_t); return __builtin_bit_cast(unsigned, r); }
DI float lo2f(unsigned u) { return __uint_as_float(u << 16); }
DI float hi2f(unsigned u) { return __uint_as_float(u & 0xffff0000u); }
template <int CTRL> DI float dpp_f(float x) { return __int_as_float(__builtin_amdgcn_update_dpp(0, __float_as_int(x), CTRL, 0xF, 0xF, true)); }
DI float red8(float x) { x += dpp_f<0xB1>(x); x += dpp_f<0x4E>(x); x += dpp_f<0x141>(x); return x; }
DI float xsum16(float x) { auto r = __builtin_amdgcn_permlane16_swap(__float_as_uint(x), __float_as_uint(x), false, false); return __uint_as_float(r[0]) + __uint_as_float(r[1]); }
DI float xsum32(float x) { auto r = __builtin_amdgcn_permlane32_swap(__float_as_uint(x), __float_as_uint(x), false, false); return __uint_as_float(r[0]) + __uint_as_float(r[1]); }
DI float wave_sum(float v) { v = red8(v); v += dpp_f<0x140>(v); return xsum32(xsum16(v)); }
DI float sigmoidf_(float x) { return __builtin_amdgcn_rcpf(1.f + __builtin_amdgcn_exp2f(-1.4426950408889634f * x)); }
DI void rope_cs(int pos, int i, float& c, float& s) {
  float inv = exp2f(-(float)i * 0.41524101186f);
  float ang = (float)pos * inv;
  float rev = ang * 0.15915494309189535f;
  rev = rev - floorf(rev);
  s = __builtin_amdgcn_sinf(rev);
  c = __builtin_amdgcn_cosf(rev);
}
DI int otid() { int t = threadIdx.x; asm volatile("" : "+v"(t)); return t; }
#define MFMA16(a, b, c) __builtin_amdgcn_mfma_f32_16x16x32_bf16((a), (b), (c), 0, 0, 0)

namespace pg8 {
#define PG8_LAS __attribute__((address_space(3)))
typedef unsigned short bf16_t;
constexpr int BM = 256, BK = 64, HALF = 128, HTB = HALF * BK * 2  , STAGE_BYTES = 8 * HTB, NXCD = 8, WGM = 8;
__host__ __device__ __forceinline__ int lds_byte(int r, int c) { const int st = (r >> 4) * 2 + (c >> 5), rr = r & 15, cc = c & 31, ob = rr * 64 + cc * 2; return st * 1024 + (ob ^ (((ob >> 9) & 1) << 5)); }
__host__ __device__ __forceinline__ void stage_rc(int b, int& R, int& C) { const int st = b / 1024, sb = b % 1024, swz = sb ^ (((sb >> 9) & 1) << 5); R = (st >> 1) * 16 + swz / 64; C = (st & 1) * 32 + (swz % 64) / 2; }
__host__ __device__ __forceinline__ int perm32(int rho) { const int n = rho >> 4, i = rho & 15; return 8 * (i >> 2) + 4 * n + (i & 3); }
struct Unit { int pm, pn; };
struct Gemm { const bf16_t* A; const bf16_t* Bt; int M, N, K; };
struct StaticOrder {
    int nM, nN, nwg, G, c;
    __host__ __device__ void init(int M, int N, int G_, int c_) { nM = M / BM; nN = N / BM; nwg = nM * nN; G = G_; c = c_; }
    __host__ __device__ bool next(int i, Unit& u) const {
        const long L = (long)i * G + c; if (L >= nwg) return false;
        int wgid = (int)L; { const int q = nwg / NXCD, r = nwg % NXCD, xcd = wgid % NXCD, off = wgid / NXCD; wgid = (xcd < r ? xcd * (q + 1) : r * (q + 1) + (xcd - r) * q) + off; }
        const int nig = WGM * nN, gid = wgid / nig, fm = gid * WGM, gsz = (nM - fm) < WGM ? (nM - fm) : WGM;
        u.pm = fm + ((wgid % nig) % gsz); u.pn = (wgid % nig) / gsz; return true;
    }
    __device__ __forceinline__ void a_ready(const Unit&) const {}
    __device__ __forceinline__ void done(const Unit&) const {}
};
template <class Epi, class Sched, bool STAMP = false>
__device__ __forceinline__ void gemm_phase(PG8_LAS unsigned char* lds, const Gemm g, const Sched& S, const Epi& E, unsigned long long* stamps) {
    const int tid = otid(), wid = __builtin_amdgcn_readfirstlane(tid >> 6), lane = tid & 63, wr = wid >> 2, wc = wid & 3, fr = lane & 15, fq = lane >> 4;
    const int K = g.K, nt = K / BK;
    unsigned voffA[2], voffB[2];
#pragma unroll
    for (int i = 0; i < 2; ++i) { int R, C; stage_rc(tid * 16 + i * 8192, R, C); const int Rb = Epi::PERM ? ((R & ~31) + perm32(R & 31)) : R;
        voffA[i] = (unsigned)(R * K + C) * 2u; voffB[i] = (unsigned)(Rb * K + C) * 2u; }
    const size_t kstep = (size_t)(BK * 2);
    const size_t hstep = (size_t)HALF * K * 2;
    const size_t tstep = 2 * hstep;
    const unsigned ldsw = (unsigned)wid * 1024u;
    const int aoff = lds_byte(wr * 64 + fr, fq * 8), boff = lds_byte(wc * 32 + fr, fq * 8);
#define PG8_SA(b, h) (((b) * 2 + (h)) * HTB)
#define PG8_SB(b, h) ((4 + (b) * 2 + (h)) * HTB)
#define PG8_STAGE(bufoff, gbase, voff) do { _Pragma("unroll") for (int _i = 0; _i < 2; ++_i) \
        __builtin_amdgcn_global_load_lds((const unsigned*)((const char*)(gbase) + (voff)[_i]), (PG8_LAS unsigned*)(lds + (bufoff) + ldsw + _i * 8192), 16, 0, 0); } while (0)
#define PG8_LDA(dst, b, h) do { _Pragma("unroll") for (int m = 0; m < 4; ++m) _Pragma("unroll") for (int k = 0; k < 2; ++k) dst[m][k] = *(const PG8_LAS bf16x8*)(lds + PG8_SA(b, h) + aoff + m * 2048 + k * 1024); } while (0)
#define PG8_LDB(dst, b, h) do { _Pragma("unroll") for (int n = 0; n < 2; ++n) _Pragma("unroll") for (int k = 0; k < 2; ++k) dst[n][k] = *(const PG8_LAS bf16x8*)(lds + PG8_SB(b, h) + boff + n * 2048 + k * 1024); } while (0)
#define PG8_MMA(ai, bj, At, Bt) do { __builtin_amdgcn_s_setprio(1); _Pragma("unroll") for (int m = 0; m < 4; ++m) _Pragma("unroll") for (int n = 0; n < 2; ++n) _Pragma("unroll") for (int k = 0; k < 2; ++k) \
        acc[ai][bj][m][n] = __builtin_amdgcn_mfma_f32_16x16x32_bf16(Bt[n][k], At[m][k], acc[ai][bj][m][n], 0, 0, 0); __builtin_amdgcn_s_setprio(0); } while (0)
#define PG8_WAIT_V(n) asm volatile("s_waitcnt vmcnt(" #n ")" ::: "memory")
#define PG8_WAIT_L(n) asm volatile("s_waitcnt lgkmcnt(" #n ")" ::: "memory")
#define PG8_BAR __builtin_amdgcn_s_barrier()
#define PG8_SCHED __builtin_amdgcn_sched_barrier(0)
    Unit cur, nxt; int ui = 0;
    if (!S.next(0, cur)) return;
    f32x4 acc[2][2][4][2];
#pragma unroll
    for (int a = 0; a < 2; ++a)
#pragma unroll
        for (int b = 0; b < 2; ++b)
#pragma unroll
            for (int m = 0; m < 4; ++m)
#pragma unroll
                for (int n = 0; n < 2; ++n) acc[a][b][m][n] = (f32x4){0.f, 0.f, 0.f, 0.f};
    bf16x8 At[4][2], B0[2][2], B1[2][2];
    const char* cA = (const char*)g.A + (size_t)cur.pm * tstep; const char* cB = (const char*)g.Bt + (size_t)cur.pn * tstep;
    S.a_ready(cur);
    PG8_STAGE(PG8_SB(0, 0), cB, voffB); PG8_STAGE(PG8_SA(0, 0), cA, voffA); PG8_STAGE(PG8_SB(0, 1), cB + hstep, voffB); PG8_STAGE(PG8_SA(0, 1), cA + hstep, voffA);
    if (wr == 1) PG8_BAR;
    PG8_WAIT_V(4); PG8_BAR;
    PG8_STAGE(PG8_SB(1, 0), cB + kstep, voffB); PG8_STAGE(PG8_SA(1, 0), cA + kstep, voffA); PG8_STAGE(PG8_SB(1, 1), cB + hstep + kstep, voffB);
    PG8_WAIT_V(6); PG8_BAR;
    for (;;) {
        const bool has_next = S.next(ui + 1, nxt);
        const char* nA = has_next ? (const char*)g.A + (size_t)nxt.pm * tstep : cA; const char* nB = has_next ? (const char*)g.Bt + (size_t)nxt.pn * tstep : cB;
        for (int t = 0; t < nt; t += 2) {
            const bool last = (t == nt - 2);
            const char* a1 = cA + (size_t)(t + 1) * kstep;
            const char* a2 = last ? nA : cA + (size_t)(t + 2) * kstep; const char* b2 = last ? nB : cB + (size_t)(t + 2) * kstep;
            const char* a3 = a2 + kstep; const char* b3 = b2 + kstep;
            if (last && has_next) S.a_ready(nxt);
            PG8_LDB(B0, 0, 0); PG8_SCHED; PG8_LDA(At, 0, 0); PG8_STAGE(PG8_SA(1, 1), a1 + hstep, voffA);
            PG8_WAIT_L(8); PG8_BAR; PG8_WAIT_L(0); PG8_MMA(0, 0, At, B0); PG8_BAR; PG8_SCHED;
            PG8_LDB(B1, 0, 1); PG8_STAGE(PG8_SB(0, 0), b2, voffB);
            PG8_BAR; PG8_WAIT_L(0); PG8_MMA(0, 1, At, B1); PG8_BAR;
            PG8_LDA(At, 0, 1); PG8_STAGE(PG8_SA(0, 0), a2, voffA);
            PG8_BAR; PG8_WAIT_L(0); PG8_MMA(1, 0, At, B0); PG8_BAR; PG8_SCHED;
            PG8_STAGE(PG8_SB(0, 1), b2 + hstep, voffB);
            PG8_WAIT_V(6); PG8_BAR; PG8_MMA(1, 1, At, B1); PG8_BAR;
            PG8_LDB(B0, 1, 0); PG8_SCHED; PG8_LDA(At, 1, 0); PG8_STAGE(PG8_SA(0, 1), a2 + hstep, voffA);
            PG8_WAIT_L(8); PG8_BAR; PG8_WAIT_L(0); PG8_MMA(0, 0, At, B0); PG8_BAR; PG8_SCHED;
            PG8_LDB(B1, 1, 1); PG8_STAGE(PG8_SB(1, 0), b3, voffB);
            PG8_BAR; PG8_WAIT_L(0); PG8_MMA(0, 1, At, B1); PG8_BAR;
            PG8_LDA(At, 1, 1); PG8_STAGE(PG8_SA(1, 0), a3, voffA);
            PG8_BAR; PG8_WAIT_L(0); PG8_MMA(1, 0, At, B0); PG8_BAR; PG8_SCHED;
            PG8_STAGE(PG8_SB(1, 1), b3 + hstep, voffB);
            PG8_WAIT_V(6); PG8_BAR; PG8_MMA(1, 1, At, B1); PG8_BAR;
        }
        if constexpr (!Epi::AFTER_DRAIN) { E(acc, cur, wr, wc, fr, fq); S.done(cur); }
        if (!has_next) break;
#pragma unroll
        for (int a = 0; a < 2; ++a)
#pragma unroll
            for (int b = 0; b < 2; ++b)
#pragma unroll
                for (int m = 0; m < 4; ++m)
#pragma unroll
                    for (int n = 0; n < 2; ++n) acc[a][b][m][n] = (f32x4){0.f, 0.f, 0.f, 0.f};
        cur = nxt; cA = nA; cB = nB; ++ui;
    }
    PG8_WAIT_V(0);
    if (wr == 0) PG8_BAR;
    PG8_BAR;
    if constexpr (Epi::AFTER_DRAIN) { E.fused(acc, cur, wr, wc, fr, fq, lds, wid, lane); S.done(cur); }
#undef PG8_SA
#undef PG8_SB
#undef PG8_STAGE
#undef PG8_LDA
#undef PG8_LDB
#undef PG8_MMA
#undef PG8_WAIT_V
#undef PG8_WAIT_L
#undef PG8_BAR
#undef PG8_SCHED
}
}

DI void store_bf4(u16* p, f32x4 v);
struct BigEpi {
  static constexpr bool PERM = true, AFTER_DRAIN = false;
  int mode, N, ld; u16* o0; u16* o1; const float* xin; float* xout; const float* gate; const float* cw; const float* cb;
  DI void f_z(int m, int n, f32x4 v) const {
    u16* dst;
    if (n < 448) dst = o0 + (size_t)m * 832 + n;
    else if (n < 1984) dst = o1 + (size_t)m * 1536 + (n - 448);
    else dst = o0 + (size_t)m * 832 + (n - 1984 + 448);
    store_bf4(dst, v);
  }
  DI void f_store(int m, int n, f32x4 v) const { store_bf4(o0 + (size_t)m * ld + n, v); }
  DI static void st8(u16* dst, f32x4 v0, f32x4 v1) {
    uint4 o; o.x = pack2(v0[0], v0[1]); o.y = pack2(v0[2], v0[3]); o.z = pack2(v1[0], v1[1]); o.w = pack2(v1[2], v1[3]);
    *(uint4*)dst = o;
  }
  DI void f_z8(int m, int n, f32x4 v0, f32x4 v1) const {
    u16* dst;
    if (n < 448) dst = o0 + (size_t)m * 832 + n;
    else if (n < 1984) dst = o1 + (size_t)m * 1536 + (n - 448);
    else dst = o0 + (size_t)m * 832 + (n - 1984 + 448);
    st8(dst, v0, v1);
  }
  DI void f_store8(int m, int n, f32x4 v0, f32x4 v1) const { st8(o0 + (size_t)m * ld + n, v0, v1); }
  DI void f_res(int m, int n, f32x4 v) const {
    const float4 g = *(const float4*)(gate + (size_t)(m >> 13) * 6144 + n);
    const float4 xi = *(const float4*)(xin + (size_t)m * DM + n);
    float4 o = {xi.x + g.x * v[0], xi.y + g.y * v[1], xi.z + g.z * v[2], xi.w + g.w * v[3]};
    *(float4*)(xout + (size_t)m * DM + n) = o;
  }
  DI void operator()(const f32x4 (&acc)[2][2][4][2], const pg8::Unit& u, int wr, int wc, int fr, int fq) const {
    const int row0 = u.pm * 256 + wr * 64 + fr, col0 = u.pn * 256 + wc * 32 + 8 * fq;
#define BIGEPI_LOOP(F, CHK) \
    _Pragma("unroll") for (int ai = 0; ai < 2; ++ai) _Pragma("unroll") for (int m = 0; m < 4; ++m) { \
      _Pragma("unroll") for (int bj = 0; bj < 2; ++bj) { \
        const int c = col0 + bj * 128; \
        if (!(CHK) || c < N) F(row0 + ai * 128 + m * 16, c, acc[ai][bj][m][0], acc[ai][bj][m][1]); } \
      __builtin_amdgcn_sched_barrier(0); }
    if (mode == 0) { if (u.pn == (DINP / 256 - 1)) { BIGEPI_LOOP(f_z8, true) } else { BIGEPI_LOOP(f_z8, false) } }
    else if (mode == 1) { BIGEPI_LOOP(f_store8, false) }
    else if (mode == 2) {
      const float* gp = gate + (size_t)(row0 >> 13) * 6144 + col0;
      float4 gt[2][2];
#pragma unroll
      for (int bj = 0; bj < 2; ++bj)
#pragma unroll
        for (int n = 0; n < 2; ++n) gt[bj][n] = *(const float4*)(gp + bj * 128 + n * 4);
#pragma unroll
      for (int ai = 0; ai < 2; ++ai)
#pragma unroll
        for (int mh = 0; mh < 2; ++mh) {
          float4 xv[2][2][2];
#pragma unroll
          for (int mm = 0; mm < 2; ++mm)
#pragma unroll
            for (int bj = 0; bj < 2; ++bj)
#pragma unroll
              for (int n = 0; n < 2; ++n)
                xv[mm][bj][n] = *(const float4*)(xin + (size_t)(row0 + ai * 128 + (mh * 2 + mm) * 16) * DM + col0 + bj * 128 + n * 4);
          __builtin_amdgcn_sched_barrier(0);
#pragma unroll
          for (int mm = 0; mm < 2; ++mm)
#pragma unroll
            for (int bj = 0; bj < 2; ++bj)
#pragma unroll
              for (int n = 0; n < 2; ++n) {
                const f32x4 v = acc[ai][bj][mh * 2 + mm][n];
                const float4 xi = xv[mm][bj][n], g = gt[bj][n];
                float4 o = {xi.x + g.x * v[0], xi.y + g.y * v[1], xi.z + g.z * v[2], xi.w + g.w * v[3]};
                *(float4*)(xout + (size_t)(row0 + ai * 128 + (mh * 2 + mm) * 16) * DM + col0 + bj * 128 + n * 4) = o;
              }
          __builtin_amdgcn_sched_barrier(0);
        }
    } else {
#pragma unroll
      for (int ai = 0; ai < 2; ++ai) {
        uint4 gs[4][2];
#pragma unroll
        for (int m = 0; m < 4; ++m)
#pragma unroll
          for (int bj = 0; bj < 2; ++bj)
            gs[m][bj] = *(const uint4*)(o0 + (size_t)(row0 + ai * 128 + m * 16) * DFF + col0 + bj * 128);
        __builtin_amdgcn_sched_barrier(0);
#pragma unroll
        for (int m = 0; m < 4; ++m)
#pragma unroll
          for (int bj = 0; bj < 2; ++bj) {
            const f32x4 v0 = acc[ai][bj][m][0], v1 = acc[ai][bj][m][1];
            const uint4 g = gs[m][bj];
            f32x4 q0 = {lo2f(g.x) * v0[0], hi2f(g.x) * v0[1], lo2f(g.y) * v0[2], hi2f(g.y) * v0[3]};
            f32x4 q1 = {lo2f(g.z) * v1[0], hi2f(g.z) * v1[1], lo2f(g.w) * v1[2], hi2f(g.w) * v1[3]};
            st8(o0 + (size_t)(row0 + ai * 128 + m * 16) * DFF + col0 + bj * 128, q0, q1);
          }
        __builtin_amdgcn_sched_barrier(0);
      }
    }
#undef BIGEPI_LOOP
  }
};
DI void gemm_big(char* smem, const u16* A, const u16* Bt, int Npad, int K, const BigEpi& E) {
  pg8::StaticOrder so; so.init(T, Npad, (int)gridDim.x, (int)blockIdx.x);
  pg8::Gemm g{A, Bt, T, Npad, K};
  pg8::gemm_phase<BigEpi, pg8::StaticOrder, false>((PG8_LAS unsigned char*)smem, g, so, E, nullptr);
}

template <class Epi>
DI void gemm_small(const u16* __restrict__ A, int lda, const u16* __restrict__ Bt, int ldb, int N, int K, u16* __restrict__ O, int ldo, Epi epi,
                   char* smem, int& rot) {
  const int tid = otid(), lane = tid & 63, wave = tid >> 6;
  const int wm = wave >> 1, wn = wave & 1, r16 = lane & 15, quad = lane >> 4;
  u16* sA = (u16*)smem;
  u16* sB = sA + 2 * 256 * 48;
  const int NT = (N + 127) >> 7;
  const int ntiles = 256 * NT;
  const int ldrow = tid >> 2, ldkc = tid & 3;
  const int KT = K >> 5;
  int first = (int)blockIdx.x - rot;
  if (first < 0) first += gridDim.x;
  rot = (rot + ntiles) % (int)gridDim.x;
  for (int tile = first; tile < ntiles; tile += gridDim.x) {
    const int grp = tile / (8 * NT), rem = tile - grp * 8 * NT;
    const int mt = grp * 8 + (rem & 7), nt = rem >> 3;
    const int m0 = mt << 8, n0 = nt << 7;
    const u16* Ap = A + (size_t)(m0 + ldrow) * lda + ldkc * 8;
    const u16* Bp = Bt + (size_t)(n0 + (ldrow & ~31) + pg8::perm32(ldrow & 31)) * ldb + ldkc * 8;
    uint4 ra0 = *(const uint4*)Ap, ra1 = *(const uint4*)(Ap + (size_t)128 * lda);
    uint4 rb0 = *(const uint4*)Bp;
    f32x4 acc[4][4];
#pragma unroll
    for (int i = 0; i < 4; ++i)
#pragma unroll
      for (int j = 0; j < 4; ++j) acc[i][j] = (f32x4){0.f, 0.f, 0.f, 0.f};
    *(uint4*)(sA + ldrow * 48 + ldkc * 8) = ra0;
    *(uint4*)(sA + (ldrow + 128) * 48 + ldkc * 8) = ra1;
    *(uint4*)(sB + ldrow * 48 + ldkc * 8) = rb0;
    __syncthreads();
    for (int kt = 0; kt < KT; ++kt) {
      const int cur = kt & 1;
      if (kt + 1 < KT) {
        const int ko = (kt + 1) << 5;
        ra0 = *(const uint4*)(Ap + ko); ra1 = *(const uint4*)(Ap + (size_t)128 * lda + ko);
        rb0 = *(const uint4*)(Bp + ko);
      }
      const u16* as = sA + cur * 256 * 48 + (wm * 64 + r16) * 48 + quad * 8;
      const u16* bs = sB + cur * 128 * 48 + (wn * 64 + r16) * 48 + quad * 8;
      bf16x8 af[4], bfr[4];
#pragma unroll
      for (int i = 0; i < 4; ++i) { af[i] = *(const bf16x8*)(as + i * 16 * 48); bfr[i] = *(const bf16x8*)(bs + i * 16 * 48); }
#pragma unroll
      for (int mi = 0; mi < 4; ++mi)
#pragma unroll
        for (int ni = 0; ni < 4; ++ni) acc[mi][ni] = MFMA16(bfr[ni], af[mi], acc[mi][ni]);
      if (kt + 1 < KT) {
        u16* a2 = sA + (cur ^ 1) * 256 * 48; u16* b2 = sB + (cur ^ 1) * 128 * 48;
        *(uint4*)(a2 + ldrow * 48 + ldkc * 8) = ra0;
        *(uint4*)(a2 + (ldrow + 128) * 48 + ldkc * 8) = ra1;
        *(uint4*)(b2 + ldrow * 48 + ldkc * 8) = rb0;
      }
      __syncthreads();
    }
#pragma unroll
    for (int mi = 0; mi < 4; ++mi) {
#pragma unroll
      for (int np = 0; np < 2; ++np) {
        const int m = m0 + wm * 64 + mi * 16 + r16;
        const int n = n0 + wn * 64 + np * 32 + quad * 8;
        if (n < N) {
          const f32x4 v0 = epi(n, acc[mi][2 * np]), v1 = epi(n + 4, acc[mi][2 * np + 1]);
          uint4 o; o.x = pack2(v0[0], v0[1]); o.y = pack2(v0[2], v0[3]); o.z = pack2(v1[0], v1[1]); o.w = pack2(v1[2], v1[3]);
          *(uint4*)(O + (size_t)m * ldo + n) = o;
        }
      }
      __builtin_amdgcn_sched_barrier(0);
    }
  }
}

DI void store_bf4(u16* p, f32x4 v) { uint2 o; o.x = pack2(v[0], v[1]); o.y = pack2(v[2], v[3]); *(uint2*)p = o; }

DI void tr_phase(const float* __restrict__ src, int ld, int K, int N, u16* __restrict__ dst, char* smem, int& rot) {
  float* tl = (float*)smem;
  const int tid = otid();
  const int KTn = K >> 5, NTn = N >> 5, ntiles = KTn * NTn;
  int first = (int)blockIdx.x - rot;
  if (first < 0) first += gridDim.x;
  rot = (rot + ntiles) % (int)gridDim.x;
  const int a = tid >> 5, bq = tid & 31;
  for (int tile = first; tile < ntiles; tile += gridDim.x) {
    const int kt = tile / NTn, nt = tile - kt * NTn;
    __syncthreads();
#pragma unroll
    for (int i = 0; i < 2; ++i) tl[(a + 16 * i) * 33 + bq] = src[(size_t)(kt * 32 + a + 16 * i) * ld + nt * 32 + bq];
    __syncthreads();
#pragma unroll
    for (int i = 0; i < 2; ++i) dst[(size_t)(nt * 32 + a + 16 * i) * K + kt * 32 + bq] = f2bf(tl[bq * 33 + a + 16 * i]);
  }
}

DI void norm_mod_phase(const float* __restrict__ X, const float* __restrict__ modl, int sh_off, int sc_off, u16* __restrict__ H) {
  const int tid_ = otid(); const int lane = tid_ & 63;
  const int gw = (blockIdx.x * NTHR + tid_) >> 6, nw = (gridDim.x * NTHR) >> 6;
  for (int t = gw * 4; t < T; t += nw * 4) {
    const float* mb = modl + (size_t)(t >> 13) * 6144;
    const float4* xr = (const float4*)(X + (size_t)t * DM);
    float4 v[4][4];
#pragma unroll
    for (int k = 0; k < 4; ++k)
#pragma unroll
      for (int i = 0; i < 4; ++i) v[k][i] = xr[k * 256 + lane + 64 * i];
    float rs[4];
#pragma unroll
    for (int k = 0; k < 4; ++k) {
      float ss = 0.f;
#pragma unroll
      for (int i = 0; i < 4; ++i) ss += v[k][i].x * v[k][i].x + v[k][i].y * v[k][i].y + v[k][i].z * v[k][i].z + v[k][i].w * v[k][i].w;
      rs[k] = rsqrtf(wave_sum(ss) * (1.f / 1024.f) + 1e-6f);
    }
#pragma unroll
    for (int i = 0; i < 4; ++i) {
      const int c = (lane + 64 * i) * 4;
      const float4 sc = *(const float4*)(mb + sc_off + c), sh = *(const float4*)(mb + sh_off + c);
#pragma unroll
      for (int k = 0; k < 4; ++k) {
        uint2 o;
        o.x = pack2(v[k][i].x * rs[k] * (1.f + sc.x) + sh.x, v[k][i].y * rs[k] * (1.f + sc.y) + sh.y);
        o.y = pack2(v[k][i].z * rs[k] * (1.f + sc.z) + sh.z, v[k][i].w * rs[k] * (1.f + sc.w) + sh.w);
        *(uint2*)(H + (size_t)(t + k) * DM + c) = o;
      }
    }
  }
}

DI void prep_phase(const Params& p, int l) {
  const u16* ZR = (const u16*)(p.ws + WS_ZREST);
  u16* QN = (u16*)(p.ws + WS_QN); u16* LA = (u16*)(p.ws + WS_LA); u16* KV = (u16*)(p.ws + WS_KV); u16* VT = (u16*)(p.ws + WS_VT);
  const float* qn_w = p.q_norm + l * 256; const float* kvn_w = p.kv_norm + l * 128;
  const float* mu0 = p.mu + (size_t)l * 2 * 1920 + 1536; const float* mu1 = mu0 + 1920;
  const int tid_ = otid(); const int lane = tid_ & 63;
  const int gw = (blockIdx.x * NTHR + tid_) >> 6, nw = (gridDim.x * NTHR) >> 6;
  const float4 qw = *(const float4*)(qn_w + lane * 4);
  const float2 kw = *(const float2*)(kvn_w + lane * 2);
  for (int grp = gw; grp < T / 8; grp += nw) {
    const int t0 = grp * 8;
    unsigned vt0[4], vt1[4];
#pragma unroll
    for (int tt = 0; tt < 8; ++tt) {
      const int t = t0 + tt, s = t & (S - 1);
      const u16* zr = ZR + (size_t)t * 832;
      {
        const uint2 q = *(const uint2*)(zr + lane * 4);
        const float a = lo2f(q.x), b = hi2f(q.x), c = lo2f(q.y), d = hi2f(q.y);
        const float ss = wave_sum(a * a + b * b + c * c + d * d);
        const float rstd = rsqrtf(ss * (1.f / 256.f) + 1e-6f);
        uint2 o; o.x = pack2(a * rstd * qw.x, b * rstd * qw.y); o.y = pack2(c * rstd * qw.z, d * rstd * qw.w);
        *(uint2*)(QN + (size_t)t * 256 + lane * 4) = o;
      }
      {
        const unsigned q = *(const unsigned*)(zr + 256 + lane * 2);
        const float a = lo2f(q), b = hi2f(q);
        const float ss = wave_sum(a * a + b * b);
        const float rstd = rsqrtf(ss * (1.f / 128.f) + 1e-6f);
        const u16 o0 = f2bf(a * rstd * kw.x), o1 = f2bf(b * rstd * kw.y);
        *(unsigned*)(KV + (size_t)t * 192 + lane * 2) = (unsigned)o0 | ((unsigned)o1 << 16);
        if (tt & 1) { vt0[tt >> 1] |= (unsigned)o0 << 16; vt1[tt >> 1] |= (unsigned)o1 << 16; }
        else { vt0[tt >> 1] = o0; vt1[tt >> 1] = o1; }
      }
      {
        const int i = lane & 31;
        const float x1 = bf2f(zr[384 + i]), x2 = bf2f(zr[416 + i]);
        float cs, sn; rope_cs(p.pos[t], i, cs, sn);
        const float o = (lane < 32) ? (x1 * cs - x2 * sn) : (x2 * cs + x1 * sn);
        KV[(size_t)t * 192 + 128 + lane] = f2bf(o);
      }
#pragma unroll
      for (int i = 0; i < 3; ++i) {
        const int cl = lane * 2 + 128 * i;
        const unsigned zc = *(const unsigned*)(zr + 448 + cl);
        const unsigned zp = (s > 0) ? *(const unsigned*)(zr - 832 + 448 + cl) : 0u;
        const unsigned zn = (s < S - 1) ? *(const unsigned*)(zr + 832 + 448 + cl) : 0u;
        const float2 m0 = *(const float2*)(mu0 + cl), m1 = *(const float2*)(mu1 + cl);
        float a = lo2f(zc), b = hi2f(zc);
        a = a + m0.x * (lo2f(zp) - a) + m1.x * (lo2f(zn) - a);
        b = b + m0.y * (hi2f(zp) - b) + m1.y * (hi2f(zn) - b);
        if (i == 0) { a = 1.f - 2.f * __builtin_amdgcn_rcpf(1.f + __builtin_amdgcn_exp2f(2.885390081777927f * a)); b = 1.f - 2.f * __builtin_amdgcn_rcpf(1.f + __builtin_amdgcn_exp2f(2.885390081777927f * b)); }
        else if (i == 2) { a = sigmoidf_(a); b = sigmoidf_(b); }
        *(unsigned*)(LA + (size_t)t * 384 + cl) = pack2(a, b);
      }
    }
    const int b = t0 >> 13, s0 = t0 & (S - 1);
    uint4 o0 = make_uint4(vt0[0], vt0[1], vt0[2], vt0[3]), o1 = make_uint4(vt1[0], vt1[1], vt1[2], vt1[3]);
    *(uint4*)(VT + ((size_t)b * 128 + lane * 2) * S + s0) = o0;
    *(uint4*)(VT + ((size_t)b * 128 + lane * 2 + 1) * S + s0) = o1;
  }
}

DI float xmax16(float x) { auto r = __builtin_amdgcn_permlane16_swap(__float_as_uint(x), __float_as_uint(x), false, false); return fmaxf(__uint_as_float(r[0]), __uint_as_float(r[1])); }
DI float xmax32(float x) { auto r = __builtin_amdgcn_permlane32_swap(__float_as_uint(x), __float_as_uint(x), false, false); return fmaxf(__uint_as_float(r[0]), __uint_as_float(r[1])); }
DI void attn_item(const Params& p, int item, char* smem) {
  const int tid = otid(), lane = tid & 63, wave = tid >> 6, r16 = lane & 15, quad = lane >> 4;
  const int h = item & 3, qb = (item >> 2) & 31, b = item >> 7;
  const u16* QP = (const u16*)(p.ws + WS_QP);
  const u16* Kg = (const u16*)(p.ws + WS_KV) + (size_t)b * S * 192;
  const u16* Vg = (const u16*)(p.ws + WS_VT) + (size_t)b * 128 * S;
  u16* OP = (u16*)(p.ws + WS_OP);
  u16* sK = (u16*)smem;
  u16* sV = sK + 64 * 208;
  const int tq0 = b * S + qb * 256 + wave * 32;
  bf16x8 qf[2][6];
#pragma unroll
  for (int g = 0; g < 2; ++g) {
    const int t = tq0 + g * 16 + r16;
    const u16* qp = QP + (size_t)t * 768 + h * 192 + quad * 8;
#pragma unroll
    for (int ks = 0; ks < 6; ++ks) qf[g][ks] = *(const bf16x8*)(qp + ks * 32);
    const int ps = p.pos[t];
#pragma unroll
    for (int j = 0; j < 8; ++j) {
      float cs, sn; rope_cs(ps, quad * 8 + j, cs, sn);
      const float x1 = bf2f((u16)qf[g][4][j]), x2 = bf2f((u16)qf[g][5][j]);
      qf[g][4][j] = (short)f2bf(x1 * cs - x2 * sn);
      qf[g][5][j] = (short)f2bf(x2 * cs + x1 * sn);
    }
  }
  f32x4 oacc[2][8];
#pragma unroll
  for (int g = 0; g < 2; ++g)
#pragma unroll
    for (int d = 0; d < 8; ++d) oacc[g][d] = (f32x4){0.f, 0.f, 0.f, 0.f};
  float m_run[2] = {-INFINITY, -INFINITY}, l_run[2] = {0.f, 0.f};
  const float cscale = 0.07216878364870322f * 1.4426950408889634f;
  const int vrow = tid >> 3, vcc = tid & 7;
#define KLD(i, base) *(const uint4*)((base) + (size_t)(tid + NTHR * (i)) * 8)
#define VLD(i, ko) *(const uint4*)(Vg + (size_t)(vrow + 64 * (i)) * S + (ko) + vcc * 8)
  uint4 rk0 = KLD(0, Kg), rk1 = KLD(1, Kg), rk2 = KLD(2, Kg);
  uint4 rv0 = VLD(0, 0), rv1 = VLD(1, 0);
#define KST(i, r) { const int c = tid + NTHR * (i); const int row = c / 24, cc = c - row * 24; *(uint4*)(sK + row * 208 + cc * 8) = r; }
#define VPERM(a_) (((((a_) >> 5) * 2 + (((a_) >> 2) & 1)) << 4) | ((((a_) >> 3) & 3) << 2) | ((a_) & 3))
#define VST(i, r) *(uint4*)(sV + VPERM(vrow + 64 * (i)) * 72 + vcc * 8) = r;
  KST(0, rk0) KST(1, rk1) KST(2, rk2)
  VST(0, rv0) VST(1, rv1)
  __syncthreads();
  { const u16* kn = Kg + (size_t)64 * 192; rk0 = KLD(0, kn); rk1 = KLD(1, kn); rk2 = KLD(2, kn); rv0 = VLD(0, 64); rv1 = VLD(1, 64); }
  for (int kt = 0; kt < S / 64; ++kt) {
    sK = (u16*)smem + (kt & 1) * 22528;
    sV = sK + 64 * 208;
    f32x4 sacc[2][4];
#pragma unroll
    for (int g = 0; g < 2; ++g)
#pragma unroll
      for (int kb = 0; kb < 4; ++kb) sacc[g][kb] = (f32x4){0.f, 0.f, 0.f, 0.f};
    {
      bf16x8 kfa[4], kfb[4];
#define KFLD(dst, ks) _Pragma("unroll") for (int kb = 0; kb < 4; ++kb) dst[kb] = *(const bf16x8*)(sK + (kb * 16 + r16) * 208 + (ks) * 32 + quad * 8);
#define KFMM(src, ks) _Pragma("unroll") for (int kb = 0; kb < 4; ++kb) { sacc[0][kb] = MFMA16(src[kb], qf[0][ks], sacc[0][kb]); sacc[1][kb] = MFMA16(src[kb], qf[1][ks], sacc[1][kb]); }
      KFLD(kfa, 0)
      __builtin_amdgcn_sched_barrier(0);
      KFLD(kfb, 1) KFMM(kfa, 0)
      __builtin_amdgcn_sched_barrier(0);
      KFLD(kfa, 2) KFMM(kfb, 1)
      __builtin_amdgcn_sched_barrier(0);
      KFLD(kfb, 3) KFMM(kfa, 2)
      __builtin_amdgcn_sched_barrier(0);
      KFLD(kfa, 4) KFMM(kfb, 3)
      __builtin_amdgcn_sched_barrier(0);
      KFLD(kfb, 5) KFMM(kfa, 4)
      __builtin_amdgcn_sched_barrier(0);
      KFMM(kfb, 5)
      __builtin_amdgcn_sched_barrier(0);
    }
    bf16x8 pf[2][2];
#pragma unroll
    for (int g = 0; g < 2; ++g) {
      float mx = sacc[g][0][0];
#pragma unroll
      for (int kb = 0; kb < 4; ++kb)
#pragma unroll
        for (int j = 0; j < 4; ++j) mx = fmaxf(mx, sacc[g][kb][j]);
      mx = xmax32(xmax16(mx));
      const float m_old = m_run[g];
      const float mnew = fmaxf(m_old, mx);
      const float alpha = __builtin_amdgcn_exp2f((m_run[g] - mnew) * cscale);
      m_run[g] = mnew;
      const float ms = mnew * cscale;
      float rs = 0.f;
      float pv[4][4];
#pragma unroll
      for (int kb = 0; kb < 4; ++kb)
#pragma unroll
        for (int j = 0; j < 4; ++j) { pv[kb][j] = __builtin_amdgcn_exp2f(sacc[g][kb][j] * cscale - ms); rs += pv[kb][j]; }
      l_run[g] = l_run[g] * alpha + rs;
      if (__builtin_amdgcn_ballot_w64(mnew > m_old) != 0ull) {
#pragma unroll
        for (int d = 0; d < 8; ++d) oacc[g][d] *= alpha;
      }
#pragma unroll
      for (int s2 = 0; s2 < 2; ++s2) {
        { uint4 pk; pk.x = pack2(pv[2 * s2][0], pv[2 * s2][1]); pk.y = pack2(pv[2 * s2][2], pv[2 * s2][3]);
          pk.z = pack2(pv[2 * s2 + 1][0], pv[2 * s2 + 1][1]); pk.w = pack2(pv[2 * s2 + 1][2], pv[2 * s2 + 1][3]);
          pf[g][s2] = __builtin_bit_cast(bf16x8, pk); }
      }
    }
    {
      bf16x8 vfa[2], vfb[2];
#define VFLD(dst, d) _Pragma("unroll") for (int s2 = 0; s2 < 2; ++s2) { \
        const uint2 v0 = *(const uint2*)(sV + ((d) * 16 + r16) * 72 + (2 * s2) * 16 + quad * 4); \
        const uint2 v1 = *(const uint2*)(sV + ((d) * 16 + r16) * 72 + (2 * s2 + 1) * 16 + quad * 4); \
        uint4 vv = make_uint4(v0.x, v0.y, v1.x, v1.y); dst[s2] = __builtin_bit_cast(bf16x8, vv); }
#define VFMM(src, d) _Pragma("unroll") for (int s2 = 0; s2 < 2; ++s2) { oacc[0][d] = MFMA16(src[s2], pf[0][s2], oacc[0][d]); oacc[1][d] = MFMA16(src[s2], pf[1][s2], oacc[1][d]); }
      VFLD(vfa, 0)
      __builtin_amdgcn_sched_barrier(0);
      VFLD(vfb, 1) VFMM(vfa, 0)
      __builtin_amdgcn_sched_barrier(0);
      VFLD(vfa, 2) VFMM(vfb, 1)
      __builtin_amdgcn_sched_barrier(0);
      VFLD(vfb, 3) VFMM(vfa, 2)
      __builtin_amdgcn_sched_barrier(0);
      VFLD(vfa, 4) VFMM(vfb, 3)
      __builtin_amdgcn_sched_barrier(0);
      VFLD(vfb, 5) VFMM(vfa, 4)
      __builtin_amdgcn_sched_barrier(0);
      VFLD(vfa, 6) VFMM(vfb, 5)
      __builtin_amdgcn_sched_barrier(0);
      VFLD(vfb, 7) VFMM(vfa, 6)
      __builtin_amdgcn_sched_barrier(0);
      VFMM(vfb, 7)
      __builtin_amdgcn_sched_barrier(0);
    }
    if (kt + 1 < S / 64) {
      sK = (u16*)smem + ((kt + 1) & 1) * 22528;
      sV = sK + 64 * 208;
      KST(0, rk0) KST(1, rk1) KST(2, rk2)
      VST(0, rv0) VST(1, rv1)
    }
    __syncthreads();
    if (kt + 2 < S / 64) {
      const u16* kn = Kg + (size_t)(kt + 2) * 64 * 192;
      const int ko = (kt + 2) * 64;
      rk0 = KLD(0, kn); rk1 = KLD(1, kn); rk2 = KLD(2, kn);
      rv0 = VLD(0, ko); rv1 = VLD(1, ko);
    }
  }
#pragma unroll
  for (int g = 0; g < 2; ++g) {
    const float l = xsum32(xsum16(l_run[g]));
    const float inv = 1.f / l;
    const int t = tq0 + g * 16 + r16;
    u16* op = OP + (size_t)t * 512 + h * 128 + quad * 8;
#pragma unroll
    for (int e = 0; e < 4; ++e) {
      const f32x4 v0 = oacc[g][2 * e] * inv, v1 = oacc[g][2 * e + 1] * inv;
      uint4 o; o.x = pack2(v0[0], v0[1]); o.y = pack2(v0[2], v0[3]); o.z = pack2(v1[0], v1[1]); o.w = pack2(v1[2], v1[3]);
      *(uint4*)(op + e * 32) = o;
    }
  }
}

DI float shift3(u16 zc, u16 zp, u16 zn, float m0, float m1) {
  const float c = bf2f(zc);
  return c + m0 * (bf2f(zp) - c) + m1 * (bf2f(zn) - c);
}
typedef float f32x2 __attribute__((ext_vector_type(2)));
DI void scan_item(const Params& p, int l, int item, char* smem) {
  const int tid = otid(), lane = tid & 63, wave = tid >> 6;
  const int dir = item & 1, bh = item >> 1, b = bh >> 3, h = bh & 7;
  float* sBase = (float*)smem;
  float* sYb = sBase + 2 * 6144;
  float* sTot = sYb + 2 * 8192;
  const u16* Z = (const u16*)(p.ws + WS_ZRKV);
  const u16* Ad = (const u16*)(p.ws + (dir ? WS_AB : WS_AF));
  const u16* Ed = (const u16*)(p.ws + (dir ? WS_EB : WS_EF));
  u16* Yd = (u16*)(p.ws + (dir ? WS_YB : WS_YF));
  constexpr int NC = S / 16;
  if (wave >= 4) {
    const int ht = tid - 256, hw = wave - 4;
    const int stl = ht >> 4, cq = ht & 15;
    const int jrow = (lane >> 4);
    const int hc = h * 64 + cq * 4;
    const float* mu0 = p.mu + (size_t)l * 2 * 1920; const float* mu1 = mu0 + 1920;
    const float4 m0r = *(const float4*)(mu0 + hc), m1r = *(const float4*)(mu1 + hc);
    const float4 m0k = *(const float4*)(mu0 + 512 + hc), m1k = *(const float4*)(mu1 + 512 + hc);
    const float4 m0v = *(const float4*)(mu0 + 1024 + hc), m1v = *(const float4*)(mu1 + 1024 + hc);
    const float4 kkw = *(const float4*)(p.k_k + l * 512 + hc), kaw = *(const float4*)(p.k_a + l * 512 + hc);
    uint2 qr0, qr1, qr2, qk0, qk1, qk2, qv0, qv1, qv2, qa, qe;
    float4 R_r, R_v, R_kd, R_b, R_nk, R_e, R_pe;
#define SCAN_PF(ci) { \
      const int step = (ci) * 16 + stl; \
      const int s_ = dir ? (S - 1 - step) : step; \
      const size_t t_ = (size_t)b * S + s_; \
      const u16* zc = Z + t_ * 1536 + hc; \
      const bool hp = s_ > 0, hn = s_ < S - 1; \
      const uint2 z2 = make_uint2(0u, 0u); \
      qr0 = *(const uint2*)zc; qk0 = *(const uint2*)(zc + 512); qv0 = *(const uint2*)(zc + 1024); \
      qr1 = hp ? *(const uint2*)(zc - 1536) : z2; qk1 = hp ? *(const uint2*)(zc + 512 - 1536) : z2; qv1 = hp ? *(const uint2*)(zc + 1024 - 1536) : z2; \
      qr2 = hn ? *(const uint2*)(zc + 1536) : z2; qk2 = hn ? *(const uint2*)(zc + 512 + 1536) : z2; qv2 = hn ? *(const uint2*)(zc + 1024 + 1536) : z2; \
      qa = *(const uint2*)(Ad + t_ * 512 + hc); qe = *(const uint2*)(Ed + t_ * 512 + hc); }
#define SH4(q0, q1, q2, m0, m1, o) { \
      float c_; \
      c_ = lo2f(q0.x); o.x = c_ + m0.x * (lo2f(q1.x) - c_) + m1.x * (lo2f(q2.x) - c_); \
      c_ = hi2f(q0.x); o.y = c_ + m0.y * (hi2f(q1.x) - c_) + m1.y * (hi2f(q2.x) - c_); \
      c_ = lo2f(q0.y); o.z = c_ + m0.z * (lo2f(q1.y) - c_) + m1.z * (lo2f(q2.y) - c_); \
      c_ = hi2f(q0.y); o.w = c_ + m0.w * (hi2f(q1.y) - c_) + m1.w * (hi2f(q2.y) - c_); }
#define UPADD(x, d) { const float t_ = __shfl_up(x, d); x += (jrow >= ((d) >> 4)) ? t_ : 0.f; }
#define SCAN_RAW(ci) { \
      float4 k4; \
      SH4(qr0, qr1, qr2, m0r, m1r, R_r) SH4(qk0, qk1, qk2, m0k, m1k, k4) SH4(qv0, qv1, qv2, m0v, m1v, R_v) \
      const float4 a4 = {lo2f(qa.x), hi2f(qa.x), lo2f(qa.y), hi2f(qa.y)}; \
      R_e = make_float4(lo2f(qe.x), hi2f(qe.x), lo2f(qe.y), hi2f(qe.y)); \
      const float4 kv = {k4.x * kkw.x, k4.y * kkw.y, k4.z * kkw.z, k4.w * kkw.w}; \
      float nrm = (kv.x * kv.x + kv.y * kv.y) + (kv.z * kv.z + kv.w * kv.w); \
      nrm = red8(nrm); nrm += dpp_f<0x140>(nrm);        \
      const float rn = rsqrtf(nrm + 1e-12f); \
      const float4 kk = {kv.x * rn, kv.y * rn, kv.z * rn, kv.w * rn}; \
      R_b = make_float4(kk.x * a4.x, kk.y * a4.y, kk.z * a4.z, kk.w * a4.w); \
      R_nk = make_float4(-kk.x, -kk.y, -kk.z, -kk.w); \
      R_kd = make_float4(k4.x * (1.f + (a4.x - 1.f) * kaw.x), k4.y * (1.f + (a4.y - 1.f) * kaw.y), k4.z * (1.f + (a4.z - 1.f) * kaw.z), k4.w * (1.f + (a4.w - 1.f) * kaw.w)); \
      R_pe = R_e;                                       \
      UPADD(R_pe.x, 16) UPADD(R_pe.y, 16) UPADD(R_pe.z, 16) UPADD(R_pe.w, 16) \
      UPADD(R_pe.x, 32) UPADD(R_pe.y, 32) UPADD(R_pe.z, 32) UPADD(R_pe.w, 32) \
      if (jrow == 3) *(float4*)(sTot + ((ci) & 1) * 256 + hw * 64 + cq * 4) = R_pe; }
#define SCAN_FIN(ci) { \
      float4 base = make_float4(0.f, 0.f, 0.f, 0.f); \
      _Pragma("unroll") for (int w_ = 0; w_ < 3; ++w_) if (w_ < hw) { \
        const float4 t4 = *(const float4*)(sTot + ((ci) & 1) * 256 + w_ * 64 + cq * 4); \
        base.x += t4.x; base.y += t4.y; base.z += t4.z; base.w += t4.w; } \
      const float4 pe = {R_pe.x + base.x, R_pe.y + base.y, R_pe.z + base.z, R_pe.w + base.w}; \
      const float4 Pt = {__expf(-pe.x), __expf(-pe.y), __expf(-pe.z), __expf(-pe.w)}; \
      const float4 Pp = {__expf(R_e.x - pe.x), __expf(R_e.y - pe.y), __expf(R_e.z - pe.z), __expf(R_e.w - pe.w)}; \
      const float4 Pi = {__expf(pe.x), __expf(pe.y), __expf(pe.z), __expf(pe.w)}; \
      float* sb_ = sBase + ((ci) & 1) * 6144 + stl * 64 + cq * 4; \
      *(float4*)(sb_) = Pt; \
      *(float4*)(sb_ + 1024) = make_float4(R_b.x * Pi.x, R_b.y * Pi.y, R_b.z * Pi.z, R_b.w * Pi.w); \
      *(float4*)(sb_ + 2048) = make_float4(R_nk.x * Pp.x, R_nk.y * Pp.y, R_nk.z * Pp.z, R_nk.w * Pp.w); \
      *(float4*)(sb_ + 3072) = make_float4(R_kd.x * Pi.x, R_kd.y * Pi.y, R_kd.z * Pi.z, R_kd.w * Pi.w); \
      *(float4*)(sb_ + 4096) = make_float4(R_r.x * Pt.x, R_r.y * Pt.y, R_r.z * Pt.z, R_r.w * Pt.w); \
      *(float4*)(sb_ + 5120) = R_v; }
#define SCAN_YOUT(ci) { \
      const int tl = ht >> 4, sl0 = (ht & 15) * 2; \
      const int step = (ci) * 16 + tl; \
      const int s_ = dir ? (S - 1 - step) : step; \
      const float* yp = sYb + ((ci) & 1) * 8192 + (tl * 32 + sl0) * 16; \
      float yo[4]; \
      _Pragma("unroll") for (int rr = 0; rr < 4; ++rr) { \
        const float4 ya_ = *(const float4*)(yp + rr * 8), yb_ = *(const float4*)(yp + rr * 8 + 4); \
        yo[rr] = ((ya_.x + ya_.y) + (ya_.z + ya_.w)) + ((yb_.x + yb_.y) + (yb_.z + yb_.w)); } \
      uint2 o; o.x = pack2(yo[0], yo[1]); o.y = pack2(yo[2], yo[3]); \
      *(uint2*)(Yd + ((size_t)b * S + s_) * 512 + h * 64 + sl0 * 2) = o; }
    SCAN_PF(0)
    SCAN_RAW(0)
    SCAN_PF(1)
    __syncthreads();
    SCAN_FIN(0)
    SCAN_RAW(1)
    SCAN_PF(2)
    __syncthreads();
    for (int ci = 0; ci < NC; ++ci) {
      if (ci + 1 < NC) {
        SCAN_FIN(ci + 1)
        if (ci + 2 < NC) {
          SCAN_RAW(ci + 2)
          if (ci + 3 < NC) SCAN_PF(ci + 3)
        }
      }
      if (ci > 0) SCAN_YOUT(ci - 1)
      __syncthreads();
    }
    SCAN_YOUT(NC - 1)
  } else {
    f32x2 a0 = {0.f, 0.f}, a1 = {0.f, 0.f}, a2 = {0.f, 0.f}, a3 = {0.f, 0.f};
    f32x2 b0 = {0.f, 0.f}, b1 = {0.f, 0.f}, b2 = {0.f, 0.f}, b3 = {0.f, 0.f};
    const int slot = wave * 8 + (lane >> 3), kq = lane & 7;
    struct VS { float4 e0, e1, n0, n1, k0, k1, r0, r1; float2 vv; };
#define SC_LOAD(X, tl) { const float* q = sb + (tl) * 64; \
      X.e0 = *(const float4*)(q + 1024); X.e1 = *(const float4*)(q + 1024 + 4); \
      X.n0 = *(const float4*)(q + 2048); X.n1 = *(const float4*)(q + 2048 + 4); \
      X.k0 = *(const float4*)(q + 3072); X.k1 = *(const float4*)(q + 3072 + 4); \
      X.r0 = *(const float4*)(q + 4096); X.r1 = *(const float4*)(q + 4096 + 4); \
      X.vv = *(const float2*)(sv + (tl) * 64); }
#define SC_STEP2(X, tl, HASP) { \
      const f32x2 nA = {X.n0.x, X.n0.y}, nB = {X.n0.z, X.n0.w}, nC = {X.n1.x, X.n1.y}, nD = {X.n1.z, X.n1.w}; \
      f32x2 sA = a0 * nA + a1 * nB; sA += a2 * nC; sA += a3 * nD; \
      f32x2 sB = b0 * nA + b1 * nB; sB += b2 * nC; sB += b3 * nD; \
      f32x2 yA = {0.f, 0.f}, yB = {0.f, 0.f}; \
      if (HASP) { \
        const f32x2 rA = {pr0.x, pr0.y}, rB = {pr0.z, pr0.w}, rC = {pr1.x, pr1.y}, rD = {pr1.z, pr1.w}; \
        yA = a0 * rA + a1 * rB; yA += a2 * rC; yA += a3 * rD; \
        yB = b0 * rA + b1 * rB; yB += b2 * rC; yB += b3 * rD; } \
      const float saA = red8(sA.x + sA.y), saB = red8(sB.x + sB.y); \
      if (HASP) { sy[((tl) - 1) * 512] = yA.x + yA.y; sy[((tl) - 1) * 512 + 8] = yB.x + yB.y; } \
      const f32x2 sav = {saA, saA}, sbv = {saB, saB}, va = {X.vv.x, X.vv.x}, vb = {X.vv.y, X.vv.y}; \
      const f32x2 eA = {X.e0.x, X.e0.y}, eB = {X.e0.z, X.e0.w}, eC = {X.e1.x, X.e1.y}, eD = {X.e1.z, X.e1.w}; \
      const f32x2 kA = {X.k0.x, X.k0.y}, kB = {X.k0.z, X.k0.w}, kC = {X.k1.x, X.k1.y}, kD = {X.k1.z, X.k1.w}; \
      a0 += va * kA; a1 += va * kB; a2 += va * kC; a3 += va * kD; \
      b0 += vb * kA; b1 += vb * kB; b2 += vb * kC; b3 += vb * kD; \
      a0 += sav * eA; a1 += sav * eB; a2 += sav * eC; a3 += sav * eD; \
      b0 += sbv * eA; b1 += sbv * eB; b2 += sbv * eC; b3 += sbv * eD; \
      pr0 = X.r0; pr1 = X.r1; }
    __syncthreads();
    __syncthreads();
    for (int ci = 0; ci < NC; ++ci) {
      const float* sb = sBase + (ci & 1) * 6144 + kq * 8;
      const float* sv = sBase + (ci & 1) * 6144 + 5120 + slot * 2;
      float* sy = sYb + (ci & 1) * 8192 + slot * 16 + kq;
      VS Q[3];
      float4 pr0, pr1;
      SC_LOAD(Q[0], 0)
      SC_LOAD(Q[1], 1)
      SC_LOAD(Q[2], 2)
      SC_STEP2(Q[0], 0, false)
#pragma unroll
      for (int tl = 1; tl < 16; ++tl) {
        if (tl + 2 < 16) SC_LOAD(Q[(tl + 2) % 3], tl + 2)
        SC_STEP2(Q[tl % 3], tl, true)
      }
      {
        const f32x2 rA = {pr0.x, pr0.y}, rB = {pr0.z, pr0.w}, rC = {pr1.x, pr1.y}, rD = {pr1.z, pr1.w};
        f32x2 yA = a0 * rA + a1 * rB; yA += a2 * rC; yA += a3 * rD;
        f32x2 yB = b0 * rA + b1 * rB; yB += b2 * rC; yB += b3 * rD;
        sy[15 * 512] = yA.x + yA.y; sy[15 * 512 + 8] = yB.x + yB.y;
        const float4 p0 = *(const float4*)(sb + 15 * 64), p1 = *(const float4*)(sb + 15 * 64 + 4);
        const f32x2 pA = {p0.x, p0.y}, pB = {p0.z, p0.w}, pC = {p1.x, p1.y}, pD = {p1.z, p1.w};
        a0 *= pA; a1 *= pB; a2 *= pC; a3 *= pD;
        b0 *= pA; b1 *= pB; b2 *= pC; b3 *= pD;
      }
      __syncthreads();
    }
  }
}

DI void unpack8(const uint4 q, float (&f)[8]) {
  f[0] = lo2f(q.x); f[1] = hi2f(q.x); f[2] = lo2f(q.y); f[3] = hi2f(q.y); f[4] = lo2f(q.z); f[5] = hi2f(q.z); f[6] = lo2f(q.w); f[7] = hi2f(q.w);
}
DI void load8f(const float* p, float (&f)[8]) {
  const float4 a = *(const float4*)p, b = *(const float4*)(p + 4);
  f[0] = a.x; f[1] = a.y; f[2] = a.z; f[3] = a.w; f[4] = b.x; f[5] = b.y; f[6] = b.z; f[7] = b.w;
}
DI void rwkv_out_phase(const Params& p, int l) {
  const u16* Z = (const u16*)(p.ws + WS_ZRKV);
  const u16* AF = (const u16*)(p.ws + WS_AF); const u16* AB = (const u16*)(p.ws + WS_AB); const u16* GG = (const u16*)(p.ws + WS_GG);
  const u16* YF = (const u16*)(p.ws + WS_YF); const u16* YB = (const u16*)(p.ws + WS_YB);
  u16* CC = (u16*)(p.ws + WS_CC);
  const float* mu0 = p.mu + (size_t)l * 2 * 1920; const float* mu1 = mu0 + 1920;
  const int tid_ = otid(); const int lane = tid_ & 63;
  const int gw = (blockIdx.x * NTHR + tid_) >> 6, nw = (gridDim.x * NTHR) >> 6;
  const int c0 = lane * 8;
  for (int t = gw; t < T; t += nw) {
    const int s = t & (S - 1);
    const bool hp = s > 0, hn = s < S - 1;
    const u16* zc = Z + (size_t)t * 1536 + c0;
    const uint4 z0 = make_uint4(0, 0, 0, 0);
    const uint4 qr = *(const uint4*)zc, qk = *(const uint4*)(zc + 512), qv = *(const uint4*)(zc + 1024);
    const uint4 pr = hp ? *(const uint4*)(zc - 1536) : z0, pk = hp ? *(const uint4*)(zc + 512 - 1536) : z0, pv = hp ? *(const uint4*)(zc + 1024 - 1536) : z0;
    const uint4 nr = hn ? *(const uint4*)(zc + 1536) : z0, nk = hn ? *(const uint4*)(zc + 512 + 1536) : z0, nv = hn ? *(const uint4*)(zc + 1024 + 1536) : z0;
    const size_t o = (size_t)t * 512 + c0;
    const uint4 qaf = *(const uint4*)(AF + o), qab = *(const uint4*)(AB + o), qg = *(const uint4*)(GG + o);
    const uint4 qyf = *(const uint4*)(YF + o), qyb = *(const uint4*)(YB + o);
    float r[8], k[8], v[8], tp[8], tn[8], ma[8], mb[8];
    unpack8(qr, r); unpack8(pr, tp); unpack8(nr, tn); load8f(mu0 + c0, ma); load8f(mu1 + c0, mb);
#pragma unroll
    for (int j = 0; j < 8; ++j) r[j] = r[j] + ma[j] * (tp[j] - r[j]) + mb[j] * (tn[j] - r[j]);
    unpack8(qk, k); unpack8(pk, tp); unpack8(nk, tn); load8f(mu0 + 512 + c0, ma); load8f(mu1 + 512 + c0, mb);
#pragma unroll
    for (int j = 0; j < 8; ++j) k[j] = k[j] + ma[j] * (tp[j] - k[j]) + mb[j] * (tn[j] - k[j]);
    unpack8(qv, v); unpack8(pv, tp); unpack8(nv, tn); load8f(mu0 + 1024 + c0, ma); load8f(mu1 + 1024 + c0, mb);
#pragma unroll
    for (int j = 0; j < 8; ++j) v[j] = v[j] + ma[j] * (tp[j] - v[j]) + mb[j] * (tn[j] - v[j]);
    float af[8], ab[8], y[8], yb[8], ka[8], rk[8];
    unpack8(qaf, af); unpack8(qab, ab); unpack8(qyf, y); unpack8(qyb, yb);
    load8f(p.k_a + l * 512 + c0, ka); load8f(p.r_k + l * 512 + c0, rk);
    float sy = 0.f, sb = 0.f;
#pragma unroll
    for (int j = 0; j < 8; ++j) {
      y[j] += yb[j]; sy += y[j];
      const float kb = k[j] * (1.f + (0.5f * (af[j] + ab[j]) - 1.f) * ka[j]);
      sb += r[j] * kb * rk[j];
    }
    const float mean = red8(sy) * (1.f / 64.f);
    const float bs = red8(sb);
    float sv = 0.f;
#pragma unroll
    for (int j = 0; j < 8; ++j) { y[j] -= mean; sv += y[j] * y[j]; }
    const float rstd = rsqrtf(red8(sv) * (1.f / 64.f) + 64e-5f);
    float g[8], gg[8], gb[8];
    unpack8(qg, g); load8f(p.gn_g + l * 512 + c0, gg); load8f(p.gn_b + l * 512 + c0, gb);
    float ov[8];
#pragma unroll
    for (int j = 0; j < 8; ++j) ov[j] = (y[j] * rstd * gg[j] + gb[j] + bs * v[j]) * g[j];
    uint4 oo; oo.x = pack2(ov[0], ov[1]); oo.y = pack2(ov[2], ov[3]); oo.z = pack2(ov[4], ov[5]); oo.w = pack2(ov[6], ov[7]);
    *(uint4*)(CC + (size_t)t * 1024 + 512 + c0) = oo;
  }
}

DI void conv_phase(const Params& p, int l) {
  const u16* G = (const u16*)(p.ws + WS_G);
  u16* GS = (u16*)(p.ws + WS_ACT);
  const float* cw = p.conv_w + (size_t)l * 3 * DFF; const float* cb = p.conv_b + (size_t)l * DFF;
  const int tid_ = otid();
  constexpr int RUN = 16;
  const int nitems = (T / RUN) * (DFF / 8);
  for (int it = blockIdx.x * NTHR + tid_; it < nitems; it += gridDim.x * NTHR) {
    const int rr = it / (DFF / 8), cg = it - rr * (DFF / 8);
    const int t0 = rr * RUN, c0 = cg * 8;
    const u16* gp = G + (size_t)t0 * DFF + c0;
    const int s0 = t0 & (S - 1);
    uint4 rows[RUN + 2];
    const uint4 z = make_uint4(0, 0, 0, 0);
    rows[0] = (s0 > 0) ? *(const uint4*)(gp - DFF) : z;
#pragma unroll
    for (int i = 0; i < RUN; ++i) rows[i + 1] = *(const uint4*)(gp + (size_t)i * DFF);
    rows[RUN + 1] = (s0 + RUN - 1 < S - 1) ? *(const uint4*)(gp + (size_t)RUN * DFF) : z;
    float w0[8], w1[8], w2[8], bb[8];
    load8f(cw + c0, w0); load8f(cw + DFF + c0, w1); load8f(cw + 2 * DFF + c0, w2); load8f(cb + c0, bb);
    float prev[8], cur[8], nxt[8];
    unpack8(rows[0], prev); unpack8(rows[1], cur);
#pragma unroll
    for (int i = 0; i < RUN; ++i) {
      unpack8(rows[i + 2], nxt);
      float o[8];
#pragma unroll
      for (int j = 0; j < 8; ++j) { const float g = w0[j] * prev[j] + w1[j] * cur[j] + w2[j] * nxt[j] + bb[j]; o[j] = g * sigmoidf_(g); }
      uint4 oo; oo.x = pack2(o[0], o[1]); oo.y = pack2(o[2], o[3]); oo.z = pack2(o[4], o[5]); oo.w = pack2(o[6], o[7]);
      *(uint4*)(GS + (size_t)(t0 + i) * DFF + c0) = oo;
#pragma unroll
      for (int j = 0; j < 8; ++j) { prev[j] = cur[j]; cur[j] = nxt[j]; }
    }
  }
}

DI void mla_out_phase(const Params& p, int l) {
  const u16* OO = (const u16*)(p.ws + WS_OO);
  u16* CC = (u16*)(p.ws + WS_CC);
  const int tid_ = otid(); const int lane = tid_ & 63;
  const int gw = (blockIdx.x * NTHR + tid_) >> 6, nw = (gridDim.x * NTHR) >> 6;
  const float* on = p.out_norm + l * 512 + lane * 8;
  const float4 w0 = *(const float4*)on, w1 = *(const float4*)(on + 4);
  for (int t = gw; t < T; t += nw) {
    const uint4 q = *(const uint4*)(OO + (size_t)t * 512 + lane * 8);
    float v[8] = {lo2f(q.x), hi2f(q.x), lo2f(q.y), hi2f(q.y), lo2f(q.z), hi2f(q.z), lo2f(q.w), hi2f(q.w)};
    float ss = 0.f;
#pragma unroll
    for (int i = 0; i < 8; ++i) ss += v[i] * v[i];
    ss = wave_sum(ss);
    const float rstd = rsqrtf(ss * (1.f / 512.f) + 1e-6f);
    uint4 o;
    o.x = pack2(v[0] * rstd * w0.x, v[1] * rstd * w0.y); o.y = pack2(v[2] * rstd * w0.z, v[3] * rstd * w0.w);
    o.z = pack2(v[4] * rstd * w1.x, v[5] * rstd * w1.y); o.w = pack2(v[6] * rstd * w1.z, v[7] * rstd * w1.w);
    *(uint4*)(CC + (size_t)t * 1024 + lane * 8) = o;
  }
}

DI void phase0(const Params& p, char* smem) {
  const int tid = otid(), lane = tid & 63, wave = tid >> 6;
  if (blockIdx.x < 384) {
    float* sc = (float*)smem;
    float* red = sc + 8192;
    for (int i = tid; i < 8192; i += NTHR) { const float cv = p.c[i]; sc[i] = cv / (1.f + __expf(-cv)); }
    __syncthreads();
    float* MOD = (float*)(p.ws + WS_MOD);
    for (int it = blockIdx.x; it < 384; it += gridDim.x) {
      const int l = it / 96, cg = it - l * 96;
      const int j = cg * 64 + lane;
      const float* wp = p.ada_w + (size_t)l * 1024 * 6144 + (size_t)(wave * 128) * 6144 + j;
      float acc[8];
#pragma unroll
      for (int bb = 0; bb < 8; ++bb) acc[bb] = 0.f;
#pragma unroll 8
      for (int i = 0; i < 128; ++i) {
        const float wv = wp[(size_t)i * 6144];
#pragma unroll
        for (int bb = 0; bb < 8; ++bb) acc[bb] += sc[bb * 1024 + wave * 128 + i] * wv;
      }
#pragma unroll
      for (int bb = 0; bb < 8; ++bb) red[(wave * 8 + bb) * 64 + lane] = acc[bb];
      __syncthreads();
      {
        const int bb = tid >> 6, jl = tid & 63;
        float v = 0.f;
#pragma unroll
        for (int w = 0; w < 8; ++w) v += red[(w * 8 + bb) * 64 + jl];
        MOD[((size_t)l * 8 + bb) * 6144 + cg * 64 + jl] = v + p.ada_b[l * 6144 + cg * 64 + jl];
      }
      __syncthreads();
    }
  }
  __syncthreads();
  {
    u16* WQ = (u16*)(p.ws + WS_WQ);
    const int total = NLAYER * 768 * 256;
    for (int id = blockIdx.x * NTHR + tid; id < total; id += gridDim.x * NTHR) {
      const int i = id & 255, n = (id >> 8) % 768, l = id / (768 * 256);
      const int h = n / 192, j = n - h * 192;
      const float* uq = p.w_uq + (size_t)l * 256 * 768 + (size_t)i * 768 + h * 192;
      float v;
      if (j < 128) {
        const float* uk = p.w_ukv + (size_t)l * 128 * 1024 + (size_t)j * 1024 + h * 256;
        float a0 = 0.f, a1 = 0.f, a2 = 0.f, a3 = 0.f;
        for (int d = 0; d < 128; d += 4) {
          const float4 x = *(const float4*)(uq + d), y = *(const float4*)(uk + d);
          a0 += x.x * y.x; a1 += x.y * y.y; a2 += x.z * y.z; a3 += x.w * y.w;
        }
        v = (a0 + a1) + (a2 + a3);
      } else v = uq[j];
      WQ[id] = f2bf(v);
    }
  }
  {
    u16* WIN = (u16*)(p.ws + WS_WIN);
    const int per = (DINP - DIN) * 1024 / 8;
    for (int id = blockIdx.x * NTHR + tid; id < NLAYER * per; id += gridDim.x * NTHR) {
      const int l = id / per, r = id - l * per;
      *(uint4*)(WIN + (size_t)l * DINP * 1024 + (size_t)DIN * 1024 + (size_t)r * 8) = make_uint4(0, 0, 0, 0);
    }
  }
  int rot = 0;
  for (int l = 0; l < NLAYER; ++l) {
    tr_phase(p.w_up + (size_t)l * 1024 * 5632, 5632, 1024, 5632, (u16*)(p.ws + WS_WUP) + (size_t)l * 5632 * 1024, smem, rot);
    tr_phase(p.w_down + (size_t)l * 2816 * 1024, 1024, 2816, 1024, (u16*)(p.ws + WS_WDN) + (size_t)l * 1024 * 2816, smem, rot);
    tr_phase(p.w_in + (size_t)l * 1024 * DIN, DIN, 1024, DIN, (u16*)(p.ws + WS_WIN) + (size_t)l * DINP * 1024, smem, rot);
    tr_phase(p.w_out + (size_t)l * 1024 * 1024, 1024, 1024, 1024, (u16*)(p.ws + WS_WOUT) + (size_t)l * 1024 * 1024, smem, rot);
    tr_phase(p.w_ukv + (size_t)l * 128 * 1024, 1024, 128, 1024, (u16*)(p.ws + WS_WUKV) + (size_t)l * 1024 * 128, smem, rot);
    tr_phase(p.g2 + (size_t)l * 128 * 512, 512, 128, 512, (u16*)(p.ws + WS_G2) + (size_t)l * 512 * 128, smem, rot);
    for (int d = 0; d < 2; ++d) {
      tr_phase(p.w2 + (size_t)(l * 2 + d) * 64 * 512, 512, 64, 512, (u16*)(p.ws + WS_W2) + (size_t)(l * 2 + d) * 512 * 64, smem, rot);
      tr_phase(p.a2 + (size_t)(l * 2 + d) * 64 * 512, 512, 64, 512, (u16*)(p.ws + WS_A2) + (size_t)(l * 2 + d) * 512 * 64, smem, rot);
    }
  }
}

#define XB_TMO      128
#define XB_XCNT(j)  (256  + 64 * (j))
#define XB_XSUB(j)  (1280 + 64 * (j))
#define XB_XGEN(j)  (2304 + 64 * (j))
#define XB_TOP      3328
#define XB_TOPGEN   3392
#define XCD_BAR_WORDS 3456
#define XB_SPIN_CAP (1u << 22)
#define LAS __attribute__((address_space(3)))

__device__ __forceinline__ unsigned xb_ld(unsigned* p)              { return __hip_atomic_load(p, __ATOMIC_RELAXED, __HIP_MEMORY_SCOPE_AGENT); }
__device__ __forceinline__ unsigned xb_add(unsigned* p, unsigned v) { return __hip_atomic_fetch_add(p, v, __ATOMIC_RELAXED, __HIP_MEMORY_SCOPE_AGENT); }
__device__ __forceinline__ unsigned xb_xcc_id() { return (unsigned)__builtin_amdgcn_s_getreg((3 << 11) | 20) & 0xFu; }
#define XB_SPIN(cond, bar) do { unsigned _sp = 0; while (cond) { __builtin_amdgcn_s_sleep(1); \
    if ((++_sp & 255u) == 0u) { if (xb_ld(&(bar)[XB_TMO])) break; if (_sp > XB_SPIN_CAP) { atomicAdd(&(bar)[XB_TMO], 1u); break; } } } } while (0)

struct XcdBarrier {
    unsigned* bar; unsigned x;
    volatile LAS unsigned* st;
};

__device__ __forceinline__ XcdBarrier xcd_barrier_post(unsigned* bar, volatile LAS unsigned* st) {
    XcdBarrier b; b.bar = bar; b.x = xb_xcc_id(); b.st = st;
    if (threadIdx.x == 0) (void)xb_add(&bar[XB_XCNT(b.x)], 1u);
    return b;
}
__device__ __forceinline__ void xcd_barrier_complete(unsigned* bar, unsigned x, unsigned& nloc, unsigned& nx) {
    const unsigned G = gridDim.x * gridDim.y * gridDim.z;
    unsigned sum, cnt, mine, sp = 0u;
    for (;;) {
        sum = 0u; cnt = 0u; mine = 0u;
#pragma unroll
        for (unsigned j = 0; j < 16; ++j) { const unsigned c = xb_ld(&bar[XB_XCNT(j)]); sum += c; cnt += (c > 0u) ? 1u : 0u; mine = (j == x) ? c : mine; }
        if (sum == G) break;
        __builtin_amdgcn_s_sleep(1);
        if ((++sp & 255u) == 0u) { if (xb_ld(&bar[XB_TMO])) break; if (sp > XB_SPIN_CAP) { atomicAdd(&bar[XB_TMO], 1u); break; } }
    }
    nloc = mine > 0u ? mine : 1u; nx = cnt > 0u ? cnt : 1u;
}

__device__ __forceinline__ void xcd_barrier(const XcdBarrier& b) {
    asm volatile("s_waitcnt vmcnt(0)" ::: "memory");
    __syncthreads();
    if (threadIdx.x == 0) {
        unsigned* bar = b.bar;
        __builtin_amdgcn_s_waitcnt(0);
        unsigned nloc = b.st[0], nx = b.st[1];
        if (nloc == 0u) { xcd_barrier_complete(bar, b.x, nloc, nx); b.st[0] = nloc; b.st[1] = nx; }
        const unsigned old = xb_add(&bar[XB_XSUB(b.x)], 1u);
        const unsigned gen = old / nloc;
        if (old + 1u == (gen + 1u) * nloc) {
            __builtin_amdgcn_fence(__ATOMIC_RELEASE, "agent");
            asm volatile("s_waitcnt vmcnt(0)" ::: "memory");
            const unsigned og = xb_add(&bar[XB_TOP], 1u);
            const unsigned tg = og / nx;
            if (og + 1u == (tg + 1u) * nx) xb_add(&bar[XB_TOPGEN], 1u);
            else XB_SPIN(xb_ld(&bar[XB_TOPGEN]) == tg, bar);
            __builtin_amdgcn_fence(__ATOMIC_ACQUIRE, "agent");
            xb_add(&bar[XB_XGEN(b.x)], 1u);
            asm volatile("s_waitcnt vmcnt(0)" ::: "memory");
        } else {
            XB_SPIN(xb_ld(&bar[XB_XGEN(b.x)]) == gen, bar);
            __builtin_amdgcn_fence(__ATOMIC_ACQUIRE, "agent");
            asm volatile("s_waitcnt vmcnt(0)" ::: "memory");
        }
    }
    __syncthreads();
}

__global__ void __launch_bounds__(512) fwd_megakernel(Params p) {
  cg::grid_group grid = cg::this_grid();
  extern __shared__ __attribute__((aligned(16))) char smem[];
  int& s_item = *(int*)(smem + 131072);
  const int tid = threadIdx.x;
  if (tid == 0) *(uint4*)(smem + 131072 + 16) = make_uint4(0u, 0u, 0u, 0u);
  __syncthreads();
  XcdBarrier xb = xcd_barrier_post((unsigned*)(p.ws + WS_BAR), (volatile LAS unsigned*)(smem + 131072 + 16));
  int* counters = (int*)(p.ws + WS_CNT);
  const float* MOD = (const float*)(p.ws + WS_MOD);
  u16* H = (u16*)(p.ws + WS_H);

  phase0(p, smem);
  grid.sync();

  for (int sg = 0; sg < NLAYER * 6; ++sg) {
    const int l = sg / 6, q = sg - l * 6;
    const float* Xin = (l == 0) ? p.x : p.out;
    float* X = p.out;
    const float* modl = MOD + (size_t)l * 8 * 6144;
    if (q == 0) {
      norm_mod_phase(Xin, modl, 0, 1024, H);
      xcd_barrier(xb);
    } else if (q == 1) {
      prep_phase(p, l);
      xcd_barrier(xb);
      int rot = 0;
      {
        const u16* LA = (const u16*)(p.ws + WS_LA);
        u16* GG = (u16*)(p.ws + WS_GG);
        gemm_small(LA + 256, 384, (const u16*)(p.ws + WS_G2) + (size_t)l * 512 * 128, 128, 512, 128, GG, 512,
                   [=](int n, f32x4 v) { return v; }, smem, rot);
        for (int d = 0; d < 2; ++d) {
          u16* AO = (u16*)(p.ws + (d ? WS_AB : WS_AF));
          const float* a0 = p.a0 + (size_t)(l * 2 + d) * 512;
          gemm_small(LA + 128 + 64 * d, 384, (const u16*)(p.ws + WS_A2) + (size_t)(l * 2 + d) * 512 * 64, 64, 512, 64, AO, 512,
                     [=](int n, f32x4 v) {
                       const float4 b = *(const float4*)(a0 + n);
                       f32x4 o = {sigmoidf_(v[0] + b.x), sigmoidf_(v[1] + b.y), sigmoidf_(v[2] + b.z), sigmoidf_(v[3] + b.w)};
                       return o;
                     }, smem, rot);
          u16* EO = (u16*)(p.ws + (d ? WS_EB : WS_EF));
          const float* w0 = p.w0 + (size_t)(l * 2 + d) * 512;
          gemm_small(LA + 64 * d, 384, (const u16*)(p.ws + WS_W2) + (size_t)(l * 2 + d) * 512 * 64, 64, 512, 64, EO, 512,
                     [=](int n, f32x4 v) {
                       const float4 b = *(const float4*)(w0 + n);
                       const float ce = 0.6065306597126334f;
                       f32x4 o = {ce * sigmoidf_(v[0] + b.x), ce * sigmoidf_(v[1] + b.y), ce * sigmoidf_(v[2] + b.z), ce * sigmoidf_(v[3] + b.w)};
                       return o;
                     }, smem, rot);
        }
      }
          } else if (q == 2) {
      int rot = 0;
      while (true) {
        __syncthreads();
        if (tid == 0) s_item = atomicAdd(&counters[l], 1);
        __syncthreads();
        const int item = s_item;
        if (item >= 128 + 1024) break;
#ifndef NO_SCAN
        if (item < 128) scan_item(p, l, item, smem);
#endif
#ifndef NO_ATTN
        if (item >= 128) attn_item(p, item - 128, smem);
#endif
      }
      xcd_barrier(xb);
      {
        rwkv_out_phase(p, l);
        const u16* OP = (const u16*)(p.ws + WS_OP); u16* OO = (u16*)(p.ws + WS_OO);
        for (int h = 0; h < 4; ++h) {
          gemm_small(OP + h * 128, 512, (const u16*)(p.ws + WS_WUKV) + (size_t)l * 1024 * 128 + (size_t)(h * 256 + 128) * 128, 128, 128, 128, OO + h * 128, 512,
                     [=](int n, f32x4 v) { return v; }, smem, rot);
        }
      }
      xcd_barrier(xb);
      mla_out_phase(p, l);
      xcd_barrier(xb);
    } else if (q == 3) {
      norm_mod_phase(X, modl, 3072, 4096, H);
      xcd_barrier(xb);
    } else if (q == 4) {
      conv_phase(p, l);
      xcd_barrier(xb);
    }
    {
      u16* G = (u16*)(p.ws + WS_G); u16* ACT = (u16*)(p.ws + WS_ACT);
      const u16* A = H; const u16* Bt; int Npad, K = 1024;
      BigEpi E{};
      if (q == 0) {
        Bt = (const u16*)(p.ws + WS_WIN) + (size_t)l * DINP * 1024; Npad = DINP;
        E.mode = 0; E.N = DIN; E.o0 = (u16*)(p.ws + WS_ZREST); E.o1 = (u16*)(p.ws + WS_ZRKV);
      } else if (q == 1) {
        A = (const u16*)(p.ws + WS_QN); Bt = (const u16*)(p.ws + WS_WQ) + (size_t)l * 768 * 256; Npad = 768; K = 256;
        E.mode = 1; E.N = 768; E.ld = 768; E.o0 = (u16*)(p.ws + WS_QP);
      } else if (q == 2) {
        A = (const u16*)(p.ws + WS_CC); Bt = (const u16*)(p.ws + WS_WOUT) + (size_t)l * 1024 * 1024; Npad = 1024;
        E.mode = 2; E.N = 1024; E.xin = Xin; E.xout = X; E.gate = modl + 2048;
      } else if (q == 3) {
        Bt = (const u16*)(p.ws + WS_WUP) + (size_t)l * 5632 * 1024; Npad = DFF;
        E.mode = 1; E.N = DFF; E.ld = DFF; E.o0 = G;
      } else if (q == 4) {
        Bt = (const u16*)(p.ws + WS_WUP) + (size_t)l * 5632 * 1024 + (size_t)DFF * 1024; Npad = DFF;
        E.mode = 3; E.N = DFF; E.o0 = ACT;
      } else {
        A = ACT; Bt = (const u16*)(p.ws + WS_WDN) + (size_t)l * 1024 * DFF; Npad = 1024; K = DFF;
        E.mode = 2; E.N = 1024; E.xin = X; E.xout = X; E.gate = modl + 5120;
      }
      gemm_big(smem, A, Bt, Npad, K, E);
    }
    xcd_barrier(xb);
  }
  {
    const int lane = tid & 63;
    const int gw = (blockIdx.x * NTHR + tid) >> 6, nw = (gridDim.x * NTHR) >> 6;
    for (int t = gw; t < T; t += nw) {
      float4* xr = (float4*)(p.out + (size_t)t * DM);
      float4 v[4];
      float ss = 0.f;
#pragma unroll
      for (int i = 0; i < 4; ++i) { v[i] = xr[lane + 64 * i]; ss += v[i].x * v[i].x + v[i].y * v[i].y + v[i].z * v[i].z + v[i].w * v[i].w; }
      ss = wave_sum(ss);
      const float rstd = rsqrtf(ss * (1.f / 1024.f) + 1e-6f);
#pragma unroll
      for (int i = 0; i < 4; ++i) {
        const float4 w = *(const float4*)(p.final_norm + (lane + 64 * i) * 4);
        float4 o = {v[i].x * rstd * w.x, v[i].y * rstd * w.y, v[i].z * rstd * w.z, v[i].w * rstd * w.w};
        xr[lane + 64 * i] = o;
      }
    }
  }
}

extern "C" void kernel_launch(void* const* d_in, const int* in_sizes, int n_in, void* d_out, int out_size, void* d_ws,
                              size_t ws_size, hipStream_t stream) {
  static int grid_blocks = 0;
  if (!grid_blocks) {
    int dev = 0, cus = 0, per_cu = 0;
    hipGetDevice(&dev);
    hipDeviceGetAttribute(&cus, hipDeviceAttributeMultiprocessorCount, dev);
    hipFuncSetAttribute((const void*)fwd_megakernel, hipFuncAttributeMaxDynamicSharedMemorySize, LDS_BYTES);
    hipOccupancyMaxActiveBlocksPerMultiprocessor(&per_cu, fwd_megakernel, NTHR, LDS_BYTES);
    if (per_cu > 1) per_cu = 1;
    if (per_cu < 1) per_cu = 1;
    grid_blocks = cus * per_cu;
    if (ws_size < WS_END) fprintf(stderr, "kernel_launch: workspace too small: %zu < %zu\n", ws_size, (size_t)WS_END);
  }
  Params p{};
  p.x = (const float*)d_in[0]; p.c = (const float*)d_in[1]; p.pos = (const int*)d_in[2]; p.ada_w = (const float*)d_in[3];
  p.ada_b = (const float*)d_in[4]; p.w_in = (const float*)d_in[5]; p.q_norm = (const float*)d_in[6]; p.w_uq = (const float*)d_in[7];
  p.kv_norm = (const float*)d_in[8]; p.w_ukv = (const float*)d_in[9]; p.out_norm = (const float*)d_in[10]; p.mu = (const float*)d_in[11];
  p.w0 = (const float*)d_in[12]; p.w2 = (const float*)d_in[13]; p.a0 = (const float*)d_in[14]; p.a2 = (const float*)d_in[15];
  p.g2 = (const float*)d_in[16]; p.k_k = (const float*)d_in[17]; p.k_a = (const float*)d_in[18]; p.r_k = (const float*)d_in[19];
  p.gn_g = (const float*)d_in[20]; p.gn_b = (const float*)d_in[21]; p.w_out = (const float*)d_in[22]; p.w_up = (const float*)d_in[23];
  p.conv_w = (const float*)d_in[24]; p.conv_b = (const float*)d_in[25]; p.w_down = (const float*)d_in[26]; p.final_norm = (const float*)d_in[27];
  p.out = (float*)d_out; p.ws = (unsigned char*)d_ws;
  hipMemsetAsync((char*)d_ws + WS_CNT, 0, 16384, stream);
  void* args[] = {&p};
  hipError_t e = hipLaunchCooperativeKernel((void*)fwd_megakernel, dim3(grid_blocks), dim3(NTHR), args, LDS_BYTES, stream);
  if (e != hipSuccess) fprintf(stderr, "cooperative launch failed: %s (grid %d)\n", hipGetErrorString(e), grid_blocks);
}
```
